# Optimizing an MI355X kernel written in HIP

```python
import math
import jax
import jax.numpy as jnp
from jax import lax
import numpy as np

D_MODEL = 1024
BATCH = 8
SEQ = 4096
DEPTH = 2

N_MEM = 256
EPS = 1e-6
ROPE_THETA = 10000.0
ATT_HEADS = 8
ATT_HEAD_DIM = 64
ATT_WIDTH = ATT_HEADS * ATT_HEAD_DIM
POOL_WIDTH = D_MODEL - ATT_WIDTH
POOL_WINDOWS = (2, 4, 8, 16)
POOL_GROUPS = len(POOL_WINDOWS)
POOL_GROUP_DIM = POOL_WIDTH // POOL_GROUPS
HY_IN_DIM = 3 * ATT_WIDTH + POOL_WIDTH
MOBA_BLOCK = 256
MOBA_TOPK = 3
Q_CHUNK = 128
SSD_EXPAND = 2
SSD_D_INNER = SSD_EXPAND * D_MODEL
SSD_HEAD_DIM = 64
SSD_HEADS = SSD_D_INNER // SSD_HEAD_DIM
SSD_GROUPS = 4
SSD_STATE = 128
SSD_CONV = 4
SSD_CHUNK = 128
SSD_CONV_DIM = SSD_D_INNER + 2 * SSD_GROUPS * SSD_STATE
SSD_IN_DIM = SSD_D_INNER + SSD_CONV_DIM + SSD_HEADS
DT_MIN = 0.001
DT_MAX = 0.1
XA_HEADS = 4
XA_HEAD_DIM = D_MODEL // XA_HEADS
D_FF = 2816
N_EXPERTS = 8
TOP_K = 2
D_FF_EXPERT = 3584
MOE_BLOCK = 256

kernel_name = 'hybrid_moba_pool_ssd_moe'


def _rmsnorm(x, gain):
    xf = x.astype(jnp.float32)
    y = xf * lax.rsqrt(jnp.mean(xf * xf, axis=-1, keepdims=True) + EPS)
    return (y * gain.astype(jnp.float32)).astype(x.dtype)


def _rope(x, positions):
    half = x.shape[-1] // 2
    inv_freq = ROPE_THETA ** (-jnp.arange(half, dtype=jnp.float32) / half)
    ang = positions.astype(jnp.float32)[:, None] * inv_freq[None, :]
    cos = jnp.cos(ang).astype(x.dtype)
    sin = jnp.sin(ang).astype(x.dtype)
    x1, x2 = x[..., :half], x[..., half:]
    return jnp.concatenate([x1 * cos - x2 * sin, x2 * cos + x1 * sin], axis=-1)


def _moba_attention(q, k, v):
    b, h, s, dh = q.shape
    n_blk = -(-s // MOBA_BLOCK)
    pad = n_blk * MOBA_BLOCK - s
    kp = jnp.pad(k, ((0, 0), (0, 0), (0, pad), (0, 0)))
    vp = jnp.pad(v, ((0, 0), (0, 0), (0, pad), (0, 0)))
    k_blocks = kp.reshape(b, h, n_blk, MOBA_BLOCK, dh)
    v_blocks = vp.reshape(b, h, n_blk, MOBA_BLOCK, dh)
    k_mean = jnp.mean(k_blocks.astype(jnp.float32), axis=3)
    scale = dh ** -0.5
    n_gate = max(n_blk, MOBA_TOPK)
    bi = jnp.arange(b)[:, None, None, None]
    hi = jnp.arange(h)[None, :, None, None]
    blk_ids = jnp.arange(n_blk)
    slot_ids = jnp.arange(MOBA_TOPK)
    local = jnp.arange(MOBA_BLOCK)

    def chunk(c):
        q0 = c * Q_CHUNK
        own = q0 // MOBA_BLOCK
        qc = lax.dynamic_slice_in_dim(q, q0, Q_CHUNK, axis=2)
        qpos = q0 + jnp.arange(Q_CHUNK)
        gate = jnp.einsum('bhqd,bhnd->bhqn', qc.astype(jnp.float32), k_mean)
        gate = jnp.where(blk_ids < own, gate, -jnp.inf)
        if n_gate > n_blk:
            gate = jnp.pad(gate, ((0, 0), (0, 0), (0, 0), (0, n_gate - n_blk)),
                           constant_values=-jnp.inf)
        _, idx = lax.top_k(gate, MOBA_TOPK)
        idx = jnp.minimum(idx, n_blk - 1)
        slot_ok = slot_ids < own
        kg = k_blocks[bi, hi, idx]
        vg = v_blocks[bi, hi, idx]
        s_sel = jnp.einsum('bhqd,bhqjkd->bhqjk', qc, kg).astype(jnp.float32) * scale
        s_sel = jnp.where(slot_ok[:, None], s_sel, -jnp.inf)
        s_sel = s_sel.reshape(b, h, Q_CHUNK, MOBA_TOPK * MOBA_BLOCK)
        k_own = lax.dynamic_slice_in_dim(kp, own * MOBA_BLOCK, MOBA_BLOCK, axis=2)
        v_own = lax.dynamic_slice_in_dim(vp, own * MOBA_BLOCK, MOBA_BLOCK, axis=2)
        kpos = own * MOBA_BLOCK + local
        s_own = jnp.einsum('bhqd,bhkd->bhqk', qc, k_own).astype(jnp.float32) * scale
        s_own = jnp.where(kpos[None, :] <= qpos[:, None], s_own, -jnp.inf)
        p = jax.nn.softmax(jnp.concatenate([s_sel, s_own], axis=-1), axis=-1).astype(v.dtype)
        p_sel = p[..., :MOBA_TOPK * MOBA_BLOCK].reshape(b, h, Q_CHUNK, MOBA_TOPK, MOBA_BLOCK)
        p_own = p[..., MOBA_TOPK * MOBA_BLOCK:]
        return (jnp.einsum('bhqjk,bhqjkd->bhqd', p_sel, vg)
                + jnp.einsum('bhqk,bhkd->bhqd', p_own, v_own))

    outs = lax.map(chunk, jnp.arange(s // Q_CHUNK))
    return outs.transpose(1, 2, 0, 3, 4).reshape(b, h, s, dh)


def _multiscale_pool(u, w_pool, pool_scale):
    b, s, _ = u.shape
    uf = u.astype(jnp.float32)
    cs = jnp.concatenate([jnp.zeros((b, 1, POOL_WIDTH), jnp.float32),
                          jnp.cumsum(uf, axis=1)], axis=1)
    t = jnp.arange(s)
    groups = []
    for g, win in enumerate(POOL_WINDOWS):
        sl = slice(g * POOL_GROUP_DIM, (g + 1) * POOL_GROUP_DIM)
        cs_g = cs[..., sl]
        lo = jnp.maximum(t + 1 - win, 0)
        cnt = jnp.minimum(t + 1, win).astype(jnp.float32)
        groups.append((cs_g[:, 1:] - cs_g[:, lo]) / cnt[None, :, None] - uf[..., sl])
    pooled = jnp.stack(groups, axis=2).astype(u.dtype)
    mixed = jnp.einsum('bsgc,gcd->bsgd', pooled, w_pool).reshape(b, s, POOL_WIDTH)
    return mixed * pool_scale


def _attn_pool_mixer(hn, positions, w_in, q_norm, k_norm, w_pool, pool_scale, w_out):
    b, s, _ = hn.shape
    proj = hn @ w_in
    q, k, v, u = jnp.split(proj, [ATT_WIDTH, 2 * ATT_WIDTH, 3 * ATT_WIDTH], axis=-1)

    def heads(t):
        return t.reshape(b, s, ATT_HEADS, ATT_HEAD_DIM).transpose(0, 2, 1, 3)

    q = _rope(_rmsnorm(heads(q), q_norm), positions)
    k = _rope(_rmsnorm(heads(k), k_norm), positions)
    a = _moba_attention(q, k, heads(v)).transpose(0, 2, 1, 3).reshape(b, s, ATT_WIDTH)
    p = _multiscale_pool(u, w_pool, pool_scale)
    return jnp.concatenate([a, p.astype(a.dtype)], axis=-1) @ w_out


def _ssd_chunked(x, dt, a, bmat, cmat):
    b, s, h, p = x.shape
    l = SSD_CHUNK
    c = s // l
    g = SSD_GROUPS
    r = h // g
    n = bmat.shape[-1]
    xdt = (x.astype(jnp.float32) * dt[..., None]).reshape(b, c, l, g, r, p)
    da = (dt * a).reshape(b, c, l, g, r)
    bm = bmat.astype(jnp.float32).reshape(b, c, l, g, n)
    cm = cmat.astype(jnp.float32).reshape(b, c, l, g, n)
    a_cum = jnp.cumsum(da, axis=2)
    causal = jnp.tril(jnp.ones((l, l), bool))
    seg = a_cum[:, :, :, None] - a_cum[:, :, None, :]
    decay = jnp.exp(jnp.where(causal[None, None, :, :, None, None], seg, -jnp.inf))
    cb = jnp.einsum('bctgn,bcsgn->bctsg', cm, bm)
    y_diag = jnp.einsum('bctsg,bctsgr,bcsgrp->bctgrp', cb, decay, xdt)
    to_end = jnp.exp(a_cum[:, :, -1:] - a_cum)
    states = jnp.einsum('bcsgn,bcsgr,bcsgrp->bcgrpn', bm, to_end, xdt)
    chunk_decay = jnp.exp(a_cum[:, :, -1])

    def carry_state(state, inp):
        st, dec = inp
        return state * dec[..., None, None] + st, state

    init = jnp.zeros((b, g, r, p, n), jnp.float32)
    _, s_in = lax.scan(carry_state, init,
                       (jnp.moveaxis(states, 1, 0), jnp.moveaxis(chunk_decay, 1, 0)))
    s_in = jnp.moveaxis(s_in, 0, 1)
    y_off = jnp.einsum('bctgn,bcgrpn,bctgr->bctgrp', cm, s_in, jnp.exp(a_cum))
    return (y_diag + y_off).reshape(b, s, h, p)


def _ssd_mixer(hn, w_in, conv_w, conv_b, dt_bias, a_log, d_skip, norm_g, w_out):
    b, s, _ = hn.shape
    proj = hn @ w_in
    z, xbc, dt = jnp.split(proj, [SSD_D_INNER, SSD_D_INNER + SSD_CONV_DIM], axis=-1)
    xpad = jnp.pad(xbc, ((0, 0), (SSD_CONV - 1, 0), (0, 0)))
    conv = xpad[:, 0:s] * conv_w[0]
    for i in range(1, SSD_CONV):
        conv = conv + xpad[:, i:i + s] * conv_w[i]
    xbc = jax.nn.silu(conv + conv_b)
    xs, bmat, cmat = jnp.split(xbc, [SSD_D_INNER, SSD_D_INNER + SSD_GROUPS * SSD_STATE], axis=-1)
    xs = xs.reshape(b, s, SSD_HEADS, SSD_HEAD_DIM)
    bmat = bmat.reshape(b, s, SSD_GROUPS, SSD_STATE)
    cmat = cmat.reshape(b, s, SSD_GROUPS, SSD_STATE)
    dt = jax.nn.softplus(dt.astype(jnp.float32) + dt_bias.astype(jnp.float32))
    a = -jnp.exp(a_log.astype(jnp.float32))
    y = _ssd_chunked(xs, dt, a, bmat, cmat)
    y = (y + d_skip.astype(jnp.float32)[:, None] * xs.astype(jnp.float32)).astype(hn.dtype)
    y = (y.reshape(b, s, SSD_D_INNER) * jax.nn.silu(z)).reshape(b, s, SSD_GROUPS, -1)
    y = _rmsnorm(y, norm_g.reshape(SSD_GROUPS, -1)).reshape(b, s, SSD_D_INNER)
    return y @ w_out


def _memory_cross_attention(hn, mem_n, w_q, w_kv, q_norm, k_norm, w_o):
    b, s, _ = hn.shape
    m = mem_n.shape[1]
    q = _rmsnorm((hn @ w_q).reshape(b, s, XA_HEADS, XA_HEAD_DIM), q_norm)
    k, v = jnp.split(mem_n @ w_kv, 2, axis=-1)
    k = _rmsnorm(k.reshape(b, m, XA_HEADS, XA_HEAD_DIM), k_norm)
    v = v.reshape(b, m, XA_HEADS, XA_HEAD_DIM)
    sc = jnp.einsum('bshd,bmhd->bhsm', q, k).astype(jnp.float32) * (XA_HEAD_DIM ** -0.5)
    p = jax.nn.softmax(sc, axis=-1).astype(v.dtype)
    o = jnp.einsum('bhsm,bmhd->bshd', p, v).reshape(b, s, D_MODEL)
    return o @ w_o


def _swiglu(hn, w_gate, w_up, w_down):
    return (jax.nn.silu(hn @ w_gate) * (hn @ w_up)) @ w_down


def _moe_swiglu(hn, w_router, w_gate, w_up, w_down):
    b, s, d = hn.shape
    n = b * s
    xt = hn.reshape(n, d)
    logits = (xt @ w_router).astype(jnp.float32)
    top_logit, top_e = lax.top_k(logits, TOP_K)
    gates = jax.nn.softmax(top_logit, axis=-1)
    e_flat = top_e.reshape(-1)
    tok_flat = jnp.arange(n * TOP_K, dtype=jnp.int32) // TOP_K
    g_flat = gates.reshape(-1)
    order = jnp.argsort(e_flat)
    e_sorted = e_flat[order]
    tok_sorted = tok_flat[order]
    g_sorted = g_flat[order]
    counts = jnp.zeros((N_EXPERTS,), jnp.int32).at[e_flat].add(1)
    start = jnp.cumsum(counts) - counts
    padded = (counts + MOE_BLOCK - 1) // MOE_BLOCK * MOE_BLOCK
    pad_end = jnp.cumsum(padded)
    pad_start = pad_end - padded
    rank = jnp.arange(n * TOP_K, dtype=jnp.int32) - start[e_sorted]
    dest = pad_start[e_sorted] + rank
    n_rows = (-(-(n * TOP_K) // MOE_BLOCK) + N_EXPERTS) * MOE_BLOCK
    n_blocks = n_rows // MOE_BLOCK
    xbuf = jnp.zeros((n_rows, d), hn.dtype).at[dest].set(xt[tok_sorted])
    blk_start = jnp.arange(n_blocks, dtype=jnp.int32) * MOE_BLOCK
    blk_e = jnp.minimum(jnp.sum(blk_start[:, None] >= pad_end[None, :], axis=1), N_EXPERTS - 1)

    def expert_block(args):
        xb, e = args
        return (jax.nn.silu(xb @ w_gate[e]) * (xb @ w_up[e])) @ w_down[e]

    ybuf = lax.map(expert_block, (xbuf.reshape(n_blocks, MOE_BLOCK, d), blk_e)).reshape(n_rows, d)
    y = jax.ops.segment_sum(ybuf[dest] * g_sorted[:, None].astype(ybuf.dtype), tok_sorted,
                            num_segments=n)
    return y.reshape(b, s, d)


def setup_inputs(seed: int = 0) -> dict:
    key = jax.random.key(seed)
    ks = iter(jax.random.split(key, 64))
    f32 = jnp.float32
    ne = (DEPTH + 1) // 2
    no = DEPTH // 2

    def w(shape, fan_in):
        return jax.random.normal(next(ks), shape, f32) * (fan_in ** -0.5)

    def gain(shape, s=0.02):
        return 1.0 + s * jax.random.normal(next(ks), shape, f32)

    x = jax.random.normal(next(ks), (BATCH, SEQ, D_MODEL), f32)
    mem = jax.random.normal(next(ks), (BATCH, N_MEM, D_MODEL), f32)
    positions = jnp.arange(SEQ, dtype=jnp.int32)
    dt0 = jnp.exp(jax.random.uniform(next(ks), (no, SSD_HEADS), f32,
                                     math.log(DT_MIN), math.log(DT_MAX)))
    ssd_dt_bias = dt0 + jnp.log(-jnp.expm1(-dt0))
    ssd_a_log = jnp.log(jax.random.uniform(next(ks), (no, SSD_HEADS), f32, 1.0, 16.0))
    return {
        'x': x,
        'mem': mem,
        'positions': positions,
        'mix_norm': gain((DEPTH, D_MODEL)),
        'xa_norm': gain((DEPTH, D_MODEL)),
        'mem_norm': gain((DEPTH, D_MODEL)),
        'ffn_norm': gain((DEPTH, D_MODEL)),
        'xa_wq': w((DEPTH, D_MODEL, D_MODEL), D_MODEL),
        'xa_wkv': w((DEPTH, D_MODEL, 2 * D_MODEL), D_MODEL),
        'xa_q_norm': gain((DEPTH, XA_HEAD_DIM)),
        'xa_k_norm': gain((DEPTH, XA_HEAD_DIM)),
        'xa_wo': w((DEPTH, D_MODEL, D_MODEL), D_MODEL),
        'hy_w_in': w((ne, D_MODEL, HY_IN_DIM), D_MODEL),
        'hy_q_norm': gain((ne, ATT_HEAD_DIM)),
        'hy_k_norm': gain((ne, ATT_HEAD_DIM)),
        'pool_w': w((ne, POOL_GROUPS, POOL_GROUP_DIM, POOL_GROUP_DIM), POOL_GROUP_DIM),
        'pool_scale': gain((ne, POOL_WIDTH), 0.1),
        'hy_w_out': w((ne, D_MODEL, D_MODEL), D_MODEL),
        'ffn_w_gate': w((ne, D_MODEL, D_FF), D_MODEL),
        'ffn_w_up': w((ne, D_MODEL, D_FF), D_MODEL),
        'ffn_w_down': w((ne, D_FF, D_MODEL), D_FF),
        'ssd_w_in': w((no, D_MODEL, SSD_IN_DIM), D_MODEL),
        'ssd_conv_w': jax.random.uniform(next(ks), (no, SSD_CONV, SSD_CONV_DIM), f32, -0.5, 0.5),
        'ssd_conv_b': 0.01 * jax.random.normal(next(ks), (no, SSD_CONV_DIM), f32),
        'ssd_dt_bias': ssd_dt_bias,
        'ssd_a_log': ssd_a_log,
        'ssd_d': gain((no, SSD_HEADS), 0.1),
        'ssd_norm': gain((no, SSD_D_INNER)),
        'ssd_w_out': w((no, SSD_D_INNER, D_MODEL), SSD_D_INNER),
        'moe_router': w((no, D_MODEL, N_EXPERTS), D_MODEL),
        'moe_w_gate': w((no, N_EXPERTS, D_MODEL, D_FF_EXPERT), D_MODEL),
        'moe_w_up': w((no, N_EXPERTS, D_MODEL, D_FF_EXPERT), D_MODEL),
        'moe_w_down': w((no, N_EXPERTS, D_FF_EXPERT, D_MODEL), D_FF_EXPERT),
    }


def reference(x, mem, positions, mix_norm, xa_norm, mem_norm, ffn_norm, xa_wq, xa_wkv,
              xa_q_norm, xa_k_norm, xa_wo, hy_w_in, hy_q_norm, hy_k_norm, pool_w, pool_scale,
              hy_w_out, ffn_w_gate, ffn_w_up, ffn_w_down, ssd_w_in, ssd_conv_w, ssd_conv_b,
              ssd_dt_bias, ssd_a_log, ssd_d, ssd_norm, ssd_w_out, moe_router, moe_w_gate,
              moe_w_up, moe_w_down):
    h = x
    for layer in range(DEPTH):
        j = layer // 2
        hn = _rmsnorm(h, mix_norm[layer])
        if layer % 2 == 0:
            h = h + _attn_pool_mixer(hn, positions, hy_w_in[j], hy_q_norm[j], hy_k_norm[j],
                                     pool_w[j], pool_scale[j], hy_w_out[j])
        else:
            h = h + _ssd_mixer(hn, ssd_w_in[j], ssd_conv_w[j], ssd_conv_b[j], ssd_dt_bias[j],
                               ssd_a_log[j], ssd_d[j], ssd_norm[j], ssd_w_out[j])
        h = h + _memory_cross_attention(_rmsnorm(h, xa_norm[layer]),
                                        _rmsnorm(mem, mem_norm[layer]), xa_wq[layer],
                                        xa_wkv[layer], xa_q_norm[layer], xa_k_norm[layer],
                                        xa_wo[layer])
        hn = _rmsnorm(h, ffn_norm[layer])
        if layer % 2 == 0:
            h = h + _swiglu(hn, ffn_w_gate[j], ffn_w_up[j], ffn_w_down[j])
        else:
            h = h + _moe_swiglu(hn, moe_router[j], moe_w_gate[j], moe_w_up[j], moe_w_down[j])
    return h
```

```cpp
#include <hip/hip_runtime.h>
#include <cstdio>
#include <cstdint>

#define LAS __attribute__((address_space(3)))
#define GAS __attribute__((address_space(1)))
typedef unsigned short bf16_t;
typedef short bf16x8 __attribute__((ext_vector_type(8)));
typedef short s16x4 __attribute__((ext_vector_type(4)));
typedef float f32x2 __attribute__((ext_vector_type(2)));
typedef float f32x4 __attribute__((ext_vector_type(4)));
typedef float f32x16 __attribute__((ext_vector_type(16)));
typedef unsigned u32x2 __attribute__((ext_vector_type(2)));
typedef unsigned u32x4 __attribute__((ext_vector_type(4)));
#define DI __device__ __forceinline__

constexpr int NTOK = 32768, DM = 1024, SEQ = 4096, NBATCH = 8, NMEM = 256;
constexpr int HY_H = 8, HY_HD = 64, ATTW = 512, POOLW = 512;
constexpr int DFF = 2816, SSD_DI = 2048, SSD_XBC = 3072, SSD_H = 32, SSD_N = 128, SSD_G = 4, ZXW = 5120, SSD_INP = 5376;
constexpr int NEXP = 8, DFE = 3584, MOE_ROWS_MAX = 264 * 256;
constexpr float EPS = 1e-6f;
constexpr int NWAVES = 8, NTHR = 512;

constexpr size_t MiB = 1u << 20;
constexpr size_t WS_CTL = 0, CTL_ZERO_BYTES = 1 * MiB;
constexpr size_t WS_ROPE = 1 * MiB;
constexpr size_t WS_SS = 2 * MiB;
constexpr size_t WS_KMP = 4 * MiB;
constexpr size_t WS_PSUM = 2 * MiB;
constexpr size_t WS_WPOOL = 4 * MiB + 512 * 1024;
constexpr size_t WS_ROUTE = 5 * MiB;
constexpr size_t WS_YSS = 7 * MiB;
constexpr size_t WS_DT = 15 * MiB;
constexpr size_t WS_WSMALL = 20 * MiB;
constexpr size_t WS_KXA = 76 * MiB;
constexpr size_t WS_VTXA = 84 * MiB;
constexpr size_t WS_MEMN = 92 * MiB;
constexpr size_t WS_HNA = 100 * MiB;
constexpr size_t WS_QKU = 164 * MiB;
constexpr size_t WS_VT = 260 * MiB;
constexpr size_t WS_AP = 292 * MiB;
constexpr size_t WS_QXA = 164 * MiB, WS_PXA = 228 * MiB, WS_OXA = 292 * MiB;
constexpr size_t WS_HID = 164 * MiB;
constexpr size_t WS_HALO = 164 * MiB;
constexpr size_t WS_ZX = 256 * MiB;
constexpr size_t WS_Y = 100 * MiB;
constexpr size_t WS_HNA2 = 256 * MiB;
constexpr size_t WS_QXA1 = 100 * MiB, WS_PXA1 = 164 * MiB, WS_OXA1 = 320 * MiB;
constexpr size_t WS_HNA3 = 384 * MiB;
constexpr size_t WS_LP = 420 * MiB;
constexpr size_t WS_WMOE = 20 * MiB;
constexpr size_t WS_XBUF = 188 * MiB;
constexpr size_t WS_HMOE = 320 * MiB;
constexpr size_t WS_WMOE8 = 20 * MiB;
constexpr size_t WS_XBUF8 = 104 * MiB;
constexpr size_t WS_YBUF = 170 * MiB;
constexpr size_t WS_HMOE8 = 302 * MiB;
constexpr size_t WM8_GU = 0, WM8_DN = (size_t)8 * 7168 * 1024;
constexpr float MOE_WSCALE = 64.f, MOE_HSCALE = 8.f;
constexpr size_t WS_END = 576 * MiB;
constexpr size_t WO_HYIN = 0;
constexpr size_t WO_HYV = WO_HYIN + (size_t)1536 * 1024;
constexpr size_t WO_HYOUT = WO_HYV + (size_t)512 * 1024;
constexpr size_t WO_XAQ = WO_HYOUT + (size_t)1024 * 1024;
constexpr size_t WO_XAK = WO_XAQ + (size_t)2 * 1024 * 1024;
constexpr size_t WO_XAV = WO_XAK + (size_t)2 * 1024 * 1024;
constexpr size_t WO_XAO = WO_XAV + (size_t)2 * 1024 * 1024;
constexpr size_t WO_FGU = WO_XAO + (size_t)2 * 1024 * 1024;
constexpr size_t WO_FDN = WO_FGU + (size_t)5632 * 1024;
constexpr size_t WO_SIN = WO_FDN + (size_t)1024 * 2816;
constexpr size_t WO_SOUT = WO_SIN + (size_t)5376 * 1024;
constexpr size_t WO_END = WO_SOUT + (size_t)1024 * 2048;
static_assert(WO_END * 2 <= 56 * MiB, "small weights fit");
constexpr size_t WS_W8 = WS_WSMALL + WO_XAQ * 2;
#ifndef FFN_FP8
#define FFN_FP8 0
#endif
#ifndef XA_FP8
#define XA_FP8 1
#endif
constexpr int XAB = XA_FP8 ? 1 : 2;
constexpr float XAWS = XA_FP8 ? 64.f : 1.f;
constexpr size_t W8_XAQ = 0, W8_XAK = 4 * MiB, W8_XAV = 8 * MiB, W8_XAO = 12 * MiB, W8_FGU = 16 * MiB, W8_FDN = 27 * MiB;
static_assert(W8_FDN + (size_t)1024 * 2816 * 2 <= (WO_SIN - WO_XAQ) * 2, "fp8 weights fit below the ssd in-projection copy");
constexpr size_t WM_GU = 0, WM_DN = (size_t)8 * 7168 * 1024;
constexpr size_t RT_E = 0, RT_G = 256 * 1024, RT_RANK = 512 * 1024, RT_DEST = 768 * 1024, RT_RS = 1024 * 1024, RT_CNT = 1152 * 1024, RT_BLKE = 1168 * 1024, RT_RSD = 1280 * 1024;
constexpr int CW_BAR = 4096;

constexpr int RING_BYTES = 131072;
constexpr int XS_OFF = RING_BYTES;
constexpr int MISC_OFF = XS_OFF + 8192;
constexpr int GT_OFF = MISC_OFF + 64;
constexpr int LDS_BYTES = 163840;

struct Params {
    const float* x; const float* mem; const int* pos;
    const float* mix_norm; const float* xa_norm; const float* mem_norm; const float* ffn_norm;
    const float* xa_wq; const float* xa_wkv; const float* xa_qn; const float* xa_kn; const float* xa_wo;
    const float* hy_w_in; const float* hy_qn; const float* hy_kn; const float* pool_w; const float* pool_scale; const float* hy_w_out;
    const float* ffn_wg; const float* ffn_wu; const float* ffn_wd;
    const float* ssd_w_in; const float* conv_w; const float* conv_b; const float* dt_bias; const float* a_log; const float* ssd_d; const float* ssd_norm; const float* ssd_w_out;
    const float* router; const float* moe_wg; const float* moe_wu; const float* moe_wd;
    float* out; unsigned char* ws;
    int ph_lo, ph_hi;
};

DI unsigned f2bf(float f) { unsigned u = __builtin_bit_cast(unsigned, f); return (u + 0x7fffu + ((u >> 16) & 1u)) >> 16; }
DI unsigned pk2(float lo, float hi) { unsigned r; asm volatile("v_cvt_pk_bf16_f32 %0, %1, %2" : "=v"(r) : "v"(lo), "v"(hi)); return r; }
DI float bf2f(unsigned short b) { return __builtin_bit_cast(float, ((unsigned)b) << 16); }
DI float bflo(unsigned w) { return __builtin_bit_cast(float, w << 16); }
DI float bfhi(unsigned w) { return __builtin_bit_cast(float, w & 0xffff0000u); }
DI unsigned pk4_fp8(float a, float b, float c, float d) { int w = 0; w = __builtin_amdgcn_cvt_pk_fp8_f32(a, b, w, false); w = __builtin_amdgcn_cvt_pk_fp8_f32(c, d, w, true); return (unsigned)w; }
DI size_t zx_off(int row, int col) { return ((size_t)(row >> 8) * 20 + (col >> 8)) * 65536 + (size_t)(row & 255) * 256 + (col & 255); }
DI float dot4f(const f32x4& a) { return (a[0] * a[0] + a[1] * a[1]) + (a[2] * a[2] + a[3] * a[3]); }
DI float silu_f(float x) { return x * __builtin_amdgcn_rcpf(1.f + __expf(-x)); }
DI int lane_id() { int r; asm volatile("v_mbcnt_lo_u32_b32 %0, -1, 0\n\tv_mbcnt_hi_u32_b32 %0, -1, %0" : "=v"(r)); return r; }
template <int O> DI float shx_c(float v) {
    if constexpr (O < 32) return __builtin_bit_cast(float, __builtin_amdgcn_ds_swizzle(__builtin_bit_cast(int, v), (O << 10) | 0x1f));
    else return __builtin_bit_cast(float, __builtin_amdgcn_ds_bpermute((lane_id() ^ O) << 2, __builtin_bit_cast(int, v)));
}
DI float shx(float v, int o) { switch (o) { case 1: return shx_c<1>(v); case 2: return shx_c<2>(v); case 4: return shx_c<4>(v); case 8: return shx_c<8>(v); case 16: return shx_c<16>(v); default: return shx_c<32>(v); } }
DI float dpp_row_sum(float x) {
    x += __builtin_bit_cast(float, __builtin_amdgcn_update_dpp(0, __builtin_bit_cast(int, x), 0xB1, 0xf, 0xf, false));
    x += __builtin_bit_cast(float, __builtin_amdgcn_update_dpp(0, __builtin_bit_cast(int, x), 0x4E, 0xf, 0xf, false));
    x += __builtin_bit_cast(float, __builtin_amdgcn_update_dpp(0, __builtin_bit_cast(int, x), 0x141, 0xf, 0xf, false));
    x += __builtin_bit_cast(float, __builtin_amdgcn_update_dpp(0, __builtin_bit_cast(int, x), 0x140, 0xf, 0xf, false));
    return x;
}
DI float shl_from(float v, int src_lane) { return __builtin_bit_cast(float, __builtin_amdgcn_ds_bpermute(src_lane << 2, __builtin_bit_cast(int, v))); }
DI float wave_incl_scan(float x) {
#define DPPF_(x_, ctrl_, rm_) __builtin_bit_cast(float, __builtin_amdgcn_update_dpp(0, __builtin_bit_cast(int, x_), ctrl_, rm_, 0xf, false))
    x += DPPF_(x, 0x111, 0xf); x += DPPF_(x, 0x112, 0xf); x += DPPF_(x, 0x114, 0xf); x += DPPF_(x, 0x118, 0xf);
    x += DPPF_(x, 0x142, 0xa);
    x += DPPF_(x, 0x143, 0xc);
#undef DPPF_
    return x;
}
DI float lane_val(float v, int l) { return __builtin_bit_cast(float, __builtin_amdgcn_readlane(__builtin_bit_cast(int, v), l)); }
DI float wave_sum(float v) {
#pragma unroll
    for (int o = 1; o < 64; o <<= 1) v += shx(v, o);
    return v;
}
#define TID_FROM_WAVE(wave_) ((wave_) * 64 + lane_id())
#define LDS_WAIT() asm volatile("s_waitcnt lgkmcnt(0)" ::: "memory")
#define VM_WAIT() asm volatile("s_waitcnt vmcnt(0)" ::: "memory")
#ifndef PG8_SP2
#define PG8_SP2 1
#endif
namespace pg8 {
constexpr int BM = 256, BK = 64, HALF = 128, HTB = HALF * BK * 2, STAGE_BYTES = 8 * HTB, NXCD = 8, WGM = 8;
__host__ __device__ __forceinline__ int lds_byte(int r, int c) { const int st = (r >> 4) * 2 + (c >> 5), rr = r & 15, cc = c & 31, ob = rr * 64 + cc * 2; return st * 1024 + (ob ^ (((ob >> 9) & 1) << 5)); }
__host__ __device__ __forceinline__ void stage_rc(int b, int& R, int& C) { const int st = b / 1024, sb = b % 1024, swz = sb ^ (((sb >> 9) & 1) << 5); R = (st >> 1) * 16 + swz / 64; C = (st & 1) * 32 + (swz % 64) / 2; }
__host__ __device__ __forceinline__ int perm32(int rho) { const int n = rho >> 4, i = rho & 15; return 8 * (i >> 2) + 4 * n + (i & 3); }

struct Unit { const char* A; const char* B; int pm, pn, kind, aux; };

DI void tile_of(int L, int nM, int nN, int& pm, int& pn) {
    const int nwg = nM * nN; int wgid = L;
    { const int q = nwg / NXCD, r = nwg % NXCD, xcd = wgid % NXCD, off = wgid / NXCD; wgid = (xcd < r ? xcd * (q + 1) : r * (q + 1) + (xcd - r) * q) + off; }
    const int nig = WGM * nN, gid = wgid / nig, fm = gid * WGM, gsz = (nM - fm) < WGM ? (nM - fm) : WGM;
    pm = fm + ((wgid % nig) % gsz); pn = (wgid % nig) / gsz;
}

typedef int v4i_t __attribute__((ext_vector_type(4)));
typedef int v8i_t __attribute__((ext_vector_type(8)));
DI v8i_t cat8(const bf16x8& a, const bf16x8& b) { return __builtin_shufflevector(__builtin_bit_cast(v4i_t, a), __builtin_bit_cast(v4i_t, b), 0, 1, 2, 3, 4, 5, 6, 7); }
template <bool PERMB, bool FP8, bool SEG = false, class Epi, class Sched>
DI void gemm_phase(LAS unsigned char* lds, const int wave_id, const int lda_b, const int ldb_b, const int kbytes, const Sched& S, const Epi& E) {
    int tid = TID_FROM_WAVE(wave_id); asm volatile("" : "+v"(tid));
    const int wid = wave_id, lane = tid & 63, wr = wid >> 2, wc = wid & 3, fr = lane & 15, fq = lane >> 4;
    const int nt = kbytes >> 7;
    unsigned voffA, voffB;
    { int R, C; stage_rc(tid * 16, R, C); const int Rb = PERMB ? ((R & ~31) + perm32(R & 31)) : R; voffA = (unsigned)(R * lda_b + C * 2); voffB = (unsigned)(Rb * ldb_b + C * 2); }
    const size_t qvoffA = (size_t)64 * lda_b, qvoffB = (size_t)64 * ldb_b;
    const size_t kstep = (size_t)(BK * 2);
    const size_t hstepA = (size_t)HALF * lda_b, hstepB = (size_t)HALF * ldb_b;
    const unsigned ldsw = (unsigned)wid * 1024u;
    const int aoff = lds_byte(wr * 64 + fr, fq * 8), boff = lds_byte(wc * 32 + fr, fq * 8);
#define PG8_SA(b, h) (((b) * 2 + (h)) * HTB)
#define PG8_SB(b, h) ((4 + (b) * 2 + (h)) * HTB)
#define PG8_STAGE(bufoff, gbase, voff) do { _Pragma("unroll") for (int _i = 0; _i < 2; ++_i) \
        __builtin_amdgcn_global_load_lds((const unsigned*)((const char*)(gbase) + _i * q##voff + (voff)), (LAS unsigned*)(lds + (bufoff) + ldsw + _i * 8192), 16, 0, 0); } while (0)
#define PG8_LDA(dst, b, h) do { _Pragma("unroll") for (int m = 0; m < 4; ++m) { const v4i_t lo_ = *(const LAS v4i_t*)(lds + PG8_SA(b, h) + aoff + m * 2048), hi_ = *(const LAS v4i_t*)(lds + PG8_SA(b, h) + aoff + m * 2048 + 1024); \
        dst[m] = __builtin_shufflevector(lo_, hi_, 0, 1, 2, 3, 4, 5, 6, 7); } } while (0)
#define PG8_LDB(dst, b, h) do { _Pragma("unroll") for (int n = 0; n < 2; ++n) { const v4i_t lo_ = *(const LAS v4i_t*)(lds + PG8_SB(b, h) + boff + n * 2048), hi_ = *(const LAS v4i_t*)(lds + PG8_SB(b, h) + boff + n * 2048 + 1024); \
        dst[n] = __builtin_shufflevector(lo_, hi_, 0, 1, 2, 3, 4, 5, 6, 7); } } while (0)
#define PG8_LO(v) __builtin_bit_cast(bf16x8, __builtin_shufflevector(v, v, 0, 1, 2, 3))
#define PG8_HI(v) __builtin_bit_cast(bf16x8, __builtin_shufflevector(v, v, 4, 5, 6, 7))
#define PG8_MMA(ai, bj, At, Bt) do { __builtin_amdgcn_s_setprio(1); _Pragma("unroll") for (int m = 0; m < 4; ++m) _Pragma("unroll") for (int n = 0; n < 2; ++n) { if constexpr (FP8) { \
        acc[ai][bj][m][n] = __builtin_amdgcn_mfma_scale_f32_16x16x128_f8f6f4(Bt[n], At[m], acc[ai][bj][m][n], 0, 0, 0, 0, 0, 0); } else { \
        acc[ai][bj][m][n] = __builtin_amdgcn_mfma_f32_16x16x32_bf16(PG8_LO(Bt[n]), PG8_LO(At[m]), acc[ai][bj][m][n], 0, 0, 0); \
        acc[ai][bj][m][n] = __builtin_amdgcn_mfma_f32_16x16x32_bf16(PG8_HI(Bt[n]), PG8_HI(At[m]), acc[ai][bj][m][n], 0, 0, 0); } } __builtin_amdgcn_s_setprio(0); } while (0)
#define PG8_WAIT_V(n) asm volatile("s_waitcnt vmcnt(" #n ")" ::: "memory")
#define PG8_WAIT_L(n) asm volatile("s_waitcnt lgkmcnt(" #n ")" ::: "memory")
#define PG8_BAR __builtin_amdgcn_s_barrier()
#define PG8_SCHED __builtin_amdgcn_sched_barrier(0)
    Unit cur, nxt; int ui = 0;
    if (!S.next(0, cur)) return;
    int ntu = nt;
    if constexpr (Sched::VAR_K) ntu = S.ktiles(cur, nt);
    f32x4 acc[2][2][4][2];
#pragma unroll
    for (int a = 0; a < 2; ++a)
#pragma unroll
        for (int b = 0; b < 2; ++b)
#pragma unroll
            for (int m = 0; m < 4; ++m)
#pragma unroll
                for (int n = 0; n < 2; ++n) acc[a][b][m][n] = (f32x4){0.f, 0.f, 0.f, 0.f};
    v8i_t At[4], B0[2], B1[2];
    const char* cA = cur.A; const char* cB = cur.B;
    if constexpr (SEG) { E.seg_prepare(cur, 0, tid); asm volatile("s_waitcnt lgkmcnt(0)" ::: "memory"); }
#if PG8_SP2
    PG8_STAGE(PG8_SB(0, 0), cB, voffB); PG8_STAGE(PG8_SB(0, 1), cB + hstepB, voffB); PG8_STAGE(PG8_SA(0, 0), cA, voffA); PG8_STAGE(PG8_SA(0, 1), cA + hstepA, voffA);
    if (wr == 1) PG8_BAR;
    PG8_WAIT_V(2); PG8_BAR;
#else
    PG8_STAGE(PG8_SB(0, 0), cB, voffB); PG8_STAGE(PG8_SA(0, 0), cA, voffA); PG8_STAGE(PG8_SB(0, 1), cB + hstepB, voffB); PG8_STAGE(PG8_SA(0, 1), cA + hstepA, voffA);
    if (wr == 1) PG8_BAR;
    PG8_WAIT_V(4); PG8_BAR;
#endif
    PG8_STAGE(PG8_SB(1, 0), cB + kstep, voffB); PG8_STAGE(PG8_SA(1, 0), cA + kstep, voffA); PG8_STAGE(PG8_SB(1, 1), cB + hstepB + kstep, voffB);
    PG8_WAIT_V(6); PG8_BAR;
    for (;;) {
        const bool has_next = S.next(ui + 1, nxt);
        const char* nA = has_next ? nxt.A : cA; const char* nB = has_next ? nxt.B : cB;
#pragma unroll 1
        for (int t = 0; t < ntu; t += 2) {
            const bool last = (t == ntu - 2);
            if constexpr (SEG) { if (t > 0 && (t & (nt / 4 - 1)) == 0) { const LAS float* tb = E.seg_tab(ui & 1) + (t / (nt / 4) - 1);
#pragma unroll
                for (int a = 0; a < 2; ++a)
#pragma unroll
                    for (int m = 0; m < 4; ++m) { const float rt = tb[(128 * a + 64 * wr + 16 * m + fr) * 4];
#pragma unroll
                        for (int b = 0; b < 2; ++b)
#pragma unroll
                            for (int n = 0; n < 2; ++n) acc[a][b][m][n] *= rt; } } }
            const char* a1 = cA + (size_t)(t + 1) * kstep;
            const char* a2 = last ? nA : cA + (size_t)(t + 2) * kstep; const char* b2 = last ? nB : cB + (size_t)(t + 2) * kstep;
            const char* a3 = a2 + kstep; const char* b3 = b2 + kstep;
#if PG8_SP2
            PG8_LDB(B0, 0, 0); PG8_LDB(B1, 0, 1); PG8_SCHED; PG8_LDA(At, 0, 0); PG8_STAGE(PG8_SA(1, 1), a1 + hstepA, voffA);
            PG8_WAIT_V(8); PG8_WAIT_L(0); PG8_BAR; PG8_MMA(0, 0, At, B0); PG8_MMA(0, 1, At, B1); PG8_BAR; PG8_SCHED;
            PG8_LDA(At, 0, 1); PG8_STAGE(PG8_SB(0, 0), b2, voffB); PG8_STAGE(PG8_SB(0, 1), b2 + hstepB, voffB); PG8_STAGE(PG8_SA(0, 0), a2, voffA);
            PG8_WAIT_V(8); PG8_WAIT_L(0); PG8_BAR; PG8_MMA(1, 0, At, B0); PG8_MMA(1, 1, At, B1); PG8_BAR; PG8_SCHED;
            PG8_LDB(B0, 1, 0); PG8_LDB(B1, 1, 1); PG8_SCHED; PG8_LDA(At, 1, 0); PG8_STAGE(PG8_SA(0, 1), a2 + hstepA, voffA);
            PG8_WAIT_V(8); PG8_WAIT_L(0); PG8_BAR; PG8_MMA(0, 0, At, B0); PG8_MMA(0, 1, At, B1); PG8_BAR; PG8_SCHED;
            PG8_LDA(At, 1, 1); PG8_STAGE(PG8_SB(1, 0), b3, voffB); PG8_STAGE(PG8_SB(1, 1), b3 + hstepB, voffB); PG8_STAGE(PG8_SA(1, 0), a3, voffA);
            PG8_WAIT_V(8); PG8_WAIT_L(0); PG8_BAR; PG8_MMA(1, 0, At, B0); PG8_MMA(1, 1, At, B1); PG8_BAR; PG8_SCHED;
#else
            PG8_LDB(B0, 0, 0); PG8_SCHED; PG8_LDA(At, 0, 0); PG8_STAGE(PG8_SA(1, 1), a1 + hstepA, voffA);
            PG8_WAIT_L(8); PG8_BAR; PG8_WAIT_L(0); PG8_MMA(0, 0, At, B0); PG8_BAR; PG8_SCHED;
            PG8_LDB(B1, 0, 1); PG8_STAGE(PG8_SB(0, 0), b2, voffB);
            PG8_BAR; PG8_WAIT_L(0); PG8_MMA(0, 1, At, B1); PG8_BAR;
            PG8_LDA(At, 0, 1); PG8_STAGE(PG8_SA(0, 0), a2, voffA);
            PG8_BAR; PG8_WAIT_L(0); PG8_MMA(1, 0, At, B0); PG8_BAR; PG8_SCHED;
            PG8_STAGE(PG8_SB(0, 1), b2 + hstepB, voffB);
            PG8_WAIT_V(6); PG8_BAR; PG8_MMA(1, 1, At, B1); PG8_BAR;
            PG8_LDB(B0, 1, 0); PG8_SCHED; PG8_LDA(At, 1, 0); PG8_STAGE(PG8_SA(0, 1), a2 + hstepA, voffA);
            PG8_WAIT_L(8); PG8_BAR; PG8_WAIT_L(0); PG8_MMA(0, 0, At, B0); PG8_BAR; PG8_SCHED;
            PG8_LDB(B1, 1, 1); PG8_STAGE(PG8_SB(1, 0), b3, voffB);
            PG8_BAR; PG8_WAIT_L(0); PG8_MMA(0, 1, At, B1); PG8_BAR;
            PG8_LDA(At, 1, 1); PG8_STAGE(PG8_SA(1, 0), a3, voffA);
            PG8_BAR; PG8_WAIT_L(0); PG8_MMA(1, 0, At, B0); PG8_BAR; PG8_SCHED;
            PG8_STAGE(PG8_SB(1, 1), b3 + hstepB, voffB);
            PG8_WAIT_V(6); PG8_BAR; PG8_MMA(1, 1, At, B1); PG8_BAR;
#endif
        }
        if (wr == 0) PG8_BAR;
        { const int le = lane_id(); if constexpr (SEG) E(acc, cur, wr, wc, le & 15, le >> 4, ui & 1); else E(acc, cur, wr, wc, le & 15, le >> 4); }
        if (!has_next) break;
#pragma unroll
        for (int a = 0; a < 2; ++a)
#pragma unroll
            for (int b = 0; b < 2; ++b)
#pragma unroll
                for (int m = 0; m < 4; ++m)
#pragma unroll
                    for (int n = 0; n < 2; ++n) acc[a][b][m][n] = (f32x4){0.f, 0.f, 0.f, 0.f};
        cur = nxt; cA = nA; cB = nB; ++ui;
        if constexpr (Sched::VAR_K) ntu = S.ktiles(cur, nt);
        if constexpr (SEG) { E.seg_prepare(cur, ui & 1, tid); asm volatile("s_waitcnt lgkmcnt(0)" ::: "memory"); }
        if (wr == 1) PG8_BAR;
    }
    PG8_WAIT_V(0);
    PG8_BAR;
#undef PG8_SA
#undef PG8_SB
#undef PG8_STAGE
#undef PG8_LDA
#undef PG8_LDB
#undef PG8_MMA
#undef PG8_LO
#undef PG8_HI
#undef PG8_WAIT_V
#undef PG8_WAIT_L
#undef PG8_BAR
#undef PG8_SCHED
}
}
#define XB_TMO      128
#define XB_XCNT(j)  (256  + 64 * (j))
#define XB_XSUB(j)  (1280 + 64 * (j))
#define XB_XGEN(j)  (2304 + 64 * (j))
#define XB_TOP      3328
#define XB_TOPGEN   3392
#define XCD_BAR_WORDS 3456
#define XB_SPIN_CAP (1u << 18)

__device__ __forceinline__ unsigned xb_ld(unsigned* p)              { return __hip_atomic_load(p, __ATOMIC_RELAXED, __HIP_MEMORY_SCOPE_AGENT); }
__device__ __forceinline__ unsigned xb_add(unsigned* p, unsigned v) { return __hip_atomic_fetch_add(p, v, __ATOMIC_RELAXED, __HIP_MEMORY_SCOPE_AGENT); }
__device__ __forceinline__ unsigned xb_xcc_id() { return (unsigned)__builtin_amdgcn_s_getreg((3 << 11) | 20) & 0xFu; }
#define XB_SPIN(cond, bar) do { unsigned _sp = 0; while (cond) { __builtin_amdgcn_s_sleep(1); \
    if ((++_sp & 255u) == 0u) { if (xb_ld(&(bar)[XB_TMO])) break; if (_sp > XB_SPIN_CAP) { atomicAdd(&(bar)[XB_TMO], 1u); break; } } } } while (0)

struct XcdBarrier {
    unsigned* bar; unsigned x;
    volatile LAS unsigned* st;
};

__device__ __forceinline__ XcdBarrier xcd_barrier_post(unsigned* bar, volatile LAS unsigned* st, const bool thread0) {
    XcdBarrier b; b.bar = bar; b.x = xb_xcc_id(); b.st = st;
    if (thread0) (void)xb_add(&bar[XB_XCNT(b.x)], 1u);
    return b;
}
__device__ __forceinline__ void xcd_barrier_complete(unsigned* bar, unsigned x, unsigned& nloc, unsigned& nx) {
    const unsigned G = gridDim.x * gridDim.y * gridDim.z;
    unsigned sum, cnt, mine, sp = 0u;
    for (;;) {
        sum = 0u; cnt = 0u; mine = 0u;
#pragma unroll
        for (unsigned j = 0; j < 16; ++j) { const unsigned c = xb_ld(&bar[XB_XCNT(j)]); sum += c; cnt += (c > 0u) ? 1u : 0u; mine = (j == x) ? c : mine; }
        if (sum == G) break;
        __builtin_amdgcn_s_sleep(1);
        if ((++sp & 255u) == 0u) { if (xb_ld(&bar[XB_TMO])) break; if (sp > XB_SPIN_CAP) { atomicAdd(&bar[XB_TMO], 1u); break; } }
    }
    nloc = mine > 0u ? mine : 1u; nx = cnt > 0u ? cnt : 1u;
}

__device__ __forceinline__ void xcd_barrier(const XcdBarrier& b, const bool thread0) {
    asm volatile("s_waitcnt vmcnt(0)" ::: "memory");
    __syncthreads();
    if (thread0) {
        unsigned* bar = b.bar;
        __builtin_amdgcn_s_waitcnt(0);
        unsigned nloc = b.st[0], nx = b.st[1];
        if (nloc == 0u) { xcd_barrier_complete(bar, b.x, nloc, nx); b.st[0] = nloc; b.st[1] = nx; }
        const unsigned old = xb_add(&bar[XB_XSUB(b.x)], 1u);
        const unsigned gen = old / nloc;
        if (old + 1u == (gen + 1u) * nloc) {
            __builtin_amdgcn_fence(__ATOMIC_RELEASE, "agent");
            asm volatile("s_waitcnt vmcnt(0)" ::: "memory");
            const unsigned og = xb_add(&bar[XB_TOP], 1u);
            const unsigned tg = og / nx;
            if (og + 1u == (tg + 1u) * nx) xb_add(&bar[XB_TOPGEN], 1u);
            else XB_SPIN(xb_ld(&bar[XB_TOPGEN]) == tg, bar);
            __builtin_amdgcn_fence(__ATOMIC_ACQUIRE, "agent");
            xb_add(&bar[XB_XGEN(b.x)], 1u);
            asm volatile("s_waitcnt vmcnt(0)" ::: "memory");
        } else {
            XB_SPIN(xb_ld(&bar[XB_XGEN(b.x)]) == gen, bar);
            __builtin_amdgcn_fence(__ATOMIC_ACQUIRE, "agent");
            asm volatile("s_waitcnt vmcnt(0)" ::: "memory");
        }
    }
    __syncthreads();
}
struct Ctx { LAS unsigned char* lds; int tid, lane, wave, G, gw, NGW; int rot; };
#define PHASE_CTX(C0) Ctx C = (C0); C.rot = 0; { int t_ = TID_FROM_WAVE(C.wave); asm volatile("" : "+v"(t_)); C.tid = t_; C.lane = t_ & 63; }

DI int p8(int l) { return 16 * ((l >> 2) & 1) + 4 * (l >> 3) + (l & 3); }
enum { MAP_NAT = 0, MAP_P8 = 1, MAP_HEAD64 = 2, MAP_GU_GATE = 3, MAP_GU_UP = 4 };
template <int MAP> DI int map_base(int n0) {
    if (MAP == MAP_HEAD64) return ((n0 >> 8) << 8) + (((n0 >> 5) & 1) << 7) + (((n0 >> 6) & 3) << 5);
    if (MAP == MAP_GU_GATE) return ((n0 >> 7) << 8) + (((n0 >> 5) & 3) << 5);
    if (MAP == MAP_GU_UP) return ((n0 >> 7) << 8) + 128 + (((n0 >> 5) & 3) << 5);
    return n0;
}
DI void cvt_item(const float* W, int ldw, int c0, int k0, bf16_t* WT, int K, int drow0, bool perm, LAS float* scr, int lane, const float* kscale = nullptr) {
#pragma unroll 8
    for (int i = 0; i < 32; ++i) { const int kk = 2 * i + (lane >> 5); float v = W[(size_t)(k0 + kk) * ldw + c0 + (lane & 31)]; if (kscale) v *= kscale[k0 + kk]; scr[kk * 33 + (lane & 31)] = v; }
    LDS_WAIT(); asm volatile("" ::: "memory");
    const int c = lane & 7;
#pragma unroll
    for (int j = 0; j < 4; ++j) { const int n = (lane >> 3) + 8 * j; const LAS float* s = scr + (8 * c) * 33 + n;
        u32x4 o; o.x = pk2(s[0 * 33], s[1 * 33]); o.y = pk2(s[2 * 33], s[3 * 33]); o.z = pk2(s[4 * 33], s[5 * 33]); o.w = pk2(s[6 * 33], s[7 * 33]);
        const int dr = drow0 + (perm ? p8(n) : n);
        *(GAS u32x4*)(WT + (size_t)dr * K + k0 + 8 * c) = o; }
    LDS_WAIT(); asm volatile("" ::: "memory");
}
template <int MAP> DI void cvt_job(Ctx& C, const float* W, int K, int ldw, int col0, int ncols, bf16_t* WT, int dbase, const float* kscale = nullptr) {
    LAS float* scr = (LAS float*)(C.lds + C.wave * 8448);
    const int nblk = ncols >> 5, nitems = (K >> 6) * nblk;
    int it0 = C.gw - C.rot; if (it0 < 0) it0 += C.NGW; C.rot = (C.rot + nitems) % C.NGW;
    for (int it = it0; it < nitems; it += C.NGW) { const int kb = it / nblk, nb = it - kb * nblk;
        cvt_item(W, ldw, col0 + 32 * nb, 64 * kb, WT, K, dbase + map_base<MAP>(32 * nb), MAP != MAP_NAT, scr, C.lane, kscale); }
}
DI void cvt_item8(const float* W, int ldw, int c0, int k0, unsigned char* WT, int K, int drow0, bool perm, LAS float* scr, int lane) {
#pragma unroll 8
    for (int i = 0; i < 32; ++i) { const int kk = 2 * i + (lane >> 5); scr[kk * 33 + (lane & 31)] = W[(size_t)(k0 + kk) * ldw + c0 + (lane & 31)]; }
    LDS_WAIT(); asm volatile("" ::: "memory");
    const int c = lane & 3;
#pragma unroll
    for (int j = 0; j < 2; ++j) { const int n = (lane >> 2) + 16 * j; const LAS float* s = scr + (16 * c) * 33 + n;
        u32x4 o;
        o.x = pk4_fp8(s[0 * 33] * MOE_WSCALE, s[1 * 33] * MOE_WSCALE, s[2 * 33] * MOE_WSCALE, s[3 * 33] * MOE_WSCALE); o.y = pk4_fp8(s[4 * 33] * MOE_WSCALE, s[5 * 33] * MOE_WSCALE, s[6 * 33] * MOE_WSCALE, s[7 * 33] * MOE_WSCALE);
        o.z = pk4_fp8(s[8 * 33] * MOE_WSCALE, s[9 * 33] * MOE_WSCALE, s[10 * 33] * MOE_WSCALE, s[11 * 33] * MOE_WSCALE); o.w = pk4_fp8(s[12 * 33] * MOE_WSCALE, s[13 * 33] * MOE_WSCALE, s[14 * 33] * MOE_WSCALE, s[15 * 33] * MOE_WSCALE);
        *(GAS u32x4*)(WT + (size_t)(drow0 + (perm ? p8(n) : n)) * K + k0 + 16 * c) = o; }
    LDS_WAIT(); asm volatile("" ::: "memory");
}
template <int MAP> DI void cvt_job8(Ctx& C, const float* W, int K, int ldw, int col0, int ncols, unsigned char* WT) {
    LAS float* scr = (LAS float*)(C.lds + C.wave * 8448);
    const int nblk = ncols >> 5, nitems = (K >> 6) * nblk;
    int it0 = C.gw - C.rot; if (it0 < 0) it0 += C.NGW; C.rot = (C.rot + nitems) % C.NGW;
    for (int it = it0; it < nitems; it += C.NGW) { const int kb = it / nblk, nb = it - kb * nblk;
        cvt_item8(W, ldw, col0 + 32 * nb, 64 * kb, WT, K, map_base<MAP>(32 * nb), MAP != MAP_NAT, scr, C.lane); }
}
DI void rms_row_to_bf16(const float* xrow, const float* gain, bf16_t* orow, int lane) {
    const GAS f32x4* xr = (const GAS f32x4*)xrow + lane; const GAS f32x4* gr = (const GAS f32x4*)gain + lane;
    f32x4 v[4]; float s = 0.f;
#pragma unroll
    for (int j = 0; j < 4; ++j) { v[j] = xr[64 * j]; s += (v[j].x * v[j].x + v[j].y * v[j].y) + (v[j].z * v[j].z + v[j].w * v[j].w); }
    const float rstd = __builtin_amdgcn_rsqf(wave_sum(s) * (1.f / 1024.f) + EPS);
    GAS u32x2* o8 = (GAS u32x2*)orow + lane;
#pragma unroll
    for (int j = 0; j < 4; ++j) { const f32x4 g = gr[64 * j]; u32x2 w; w.x = pk2(v[j].x * rstd * g.x, v[j].y * rstd * g.y); w.y = pk2(v[j].z * rstd * g.z, v[j].w * rstd * g.w); o8[64 * j] = w; }
}

template <int NR> DI void rms_rows_to_bf16(const float* x, const float* gain, bf16_t* o, int m0, int rstride, int lane) {
    f32x4 v[NR][4]; float s[NR];
#pragma unroll
    for (int i = 0; i < NR; ++i) { const GAS f32x4* xr = (const GAS f32x4*)(x + (size_t)(m0 + i * rstride) * DM) + lane;
#pragma unroll
        for (int j = 0; j < 4; ++j) v[i][j] = xr[64 * j]; }
    const GAS f32x4* gr = (const GAS f32x4*)gain + lane; f32x4 g[4];
#pragma unroll
    for (int j = 0; j < 4; ++j) g[j] = gr[64 * j];
#pragma unroll
    for (int i = 0; i < NR; ++i) { float a = 0.f;
#pragma unroll
        for (int j = 0; j < 4; ++j) a += dot4f(v[i][j]);
        s[i] = __builtin_amdgcn_rsqf(wave_sum(a) * (1.f / 1024.f) + EPS); }
#pragma unroll
    for (int i = 0; i < NR; ++i) { GAS u32x2* o8 = (GAS u32x2*)(o + (size_t)(m0 + i * rstride) * DM) + lane;
#pragma unroll
        for (int j = 0; j < 4; ++j) { const f32x4 t = v[i][j] * s[i] * g[j]; u32x2 w; w.x = pk2(t[0], t[1]); w.y = pk2(t[2], t[3]); o8[64 * j] = w; } }
}
DI void rms_row_to_fp8(const float* xrow, const float* gain, unsigned char* orow, int lane) {
    const GAS f32x4* xr = (const GAS f32x4*)xrow + lane; const GAS f32x4* gr = (const GAS f32x4*)gain + lane;
    f32x4 v[4]; float s = 0.f;
#pragma unroll
    for (int j = 0; j < 4; ++j) { v[j] = xr[64 * j]; s += (v[j].x * v[j].x + v[j].y * v[j].y) + (v[j].z * v[j].z + v[j].w * v[j].w); }
    const float rstd = __builtin_amdgcn_rsqf(wave_sum(s) * (1.f / 1024.f) + EPS);
    GAS unsigned* o4 = (GAS unsigned*)orow + lane;
#pragma unroll
    for (int j = 0; j < 4; ++j) { const f32x4 g = gr[64 * j]; o4[64 * j] = pk4_fp8(v[j].x * rstd * g.x, v[j].y * rstd * g.y, v[j].z * rstd * g.z, v[j].w * rstd * g.w); }
}
DI void p0_prologue(const Params& P, const Ctx& C0) {
    PHASE_CTX(C0);
    bf16_t* WS = (bf16_t*)(P.ws + WS_WSMALL);
    cvt_job<MAP_HEAD64>(C, P.hy_w_in, 1024, 2048, 0, 512, WS + WO_HYIN, 0);
    cvt_job<MAP_HEAD64>(C, P.hy_w_in, 1024, 2048, 512, 512, WS + WO_HYIN, 512);
    cvt_job<MAP_P8>(C, P.hy_w_in, 1024, 2048, 1536, 512, WS + WO_HYIN, 1024);
    cvt_job<MAP_NAT>(C, P.hy_w_in, 1024, 2048, 1024, 512, WS + WO_HYV, 0);
    cvt_job<MAP_P8>(C, P.hy_w_out, 1024, 1024, 0, 1024, WS + WO_HYOUT, 0);
    unsigned char* W8 = P.ws + WS_W8;
    for (int l = 0; l < 2; ++l) {
#if XA_FP8
        cvt_job8<MAP_P8>(C, P.xa_wq + (size_t)l * 1024 * 1024, 1024, 1024, 0, 1024, W8 + W8_XAQ + (size_t)l * 1024 * 1024);
        cvt_job8<MAP_P8>(C, P.xa_wkv + (size_t)l * 1024 * 2048, 1024, 2048, 0, 1024, W8 + W8_XAK + (size_t)l * 1024 * 1024);
        cvt_job8<MAP_NAT>(C, P.xa_wkv + (size_t)l * 1024 * 2048, 1024, 2048, 1024, 1024, W8 + W8_XAV + (size_t)l * 1024 * 1024);
        cvt_job8<MAP_P8>(C, P.xa_wo + (size_t)l * 1024 * 1024, 1024, 1024, 0, 1024, W8 + W8_XAO + (size_t)l * 1024 * 1024);
#else
        cvt_job<MAP_P8>(C, P.xa_wq + (size_t)l * 1024 * 1024, 1024, 1024, 0, 1024, (bf16_t*)(W8 + W8_XAQ) + (size_t)l * 1024 * 1024, 0);
        cvt_job<MAP_P8>(C, P.xa_wkv + (size_t)l * 1024 * 2048, 1024, 2048, 0, 1024, (bf16_t*)(W8 + W8_XAK) + (size_t)l * 1024 * 1024, 0);
        cvt_job<MAP_NAT>(C, P.xa_wkv + (size_t)l * 1024 * 2048, 1024, 2048, 1024, 1024, (bf16_t*)(W8 + W8_XAV) + (size_t)l * 1024 * 1024, 0);
        cvt_job<MAP_P8>(C, P.xa_wo + (size_t)l * 1024 * 1024, 1024, 1024, 0, 1024, (bf16_t*)(W8 + W8_XAO) + (size_t)l * 1024 * 1024, 0);
#endif
    }
#if FFN_FP8
    cvt_job8<MAP_GU_GATE>(C, P.ffn_wg, 1024, DFF, 0, DFF, W8 + W8_FGU);
    cvt_job8<MAP_GU_UP>(C, P.ffn_wu, 1024, DFF, 0, DFF, W8 + W8_FGU);
    cvt_job8<MAP_P8>(C, P.ffn_wd, DFF, 1024, 0, 1024, W8 + W8_FDN);
#else
    cvt_job<MAP_GU_GATE>(C, P.ffn_wg, 1024, DFF, 0, DFF, (bf16_t*)(W8 + W8_FGU), 0);
    cvt_job<MAP_GU_UP>(C, P.ffn_wu, 1024, DFF, 0, DFF, (bf16_t*)(W8 + W8_FGU), 0);
    cvt_job<MAP_P8>(C, P.ffn_wd, DFF, 1024, 0, 1024, (bf16_t*)(W8 + W8_FDN), 0);
#endif
    cvt_job<MAP_P8>(C, P.ssd_w_in, 1024, 5152, 0, 5120, WS + WO_SIN, 0);
    cvt_job<MAP_NAT>(C, P.ssd_w_in, 1024, 5152, 5120, 32, WS + WO_SIN, 5120);
    cvt_job<MAP_P8>(C, P.ssd_w_out, 2048, 1024, 0, 1024, WS + WO_SOUT, 0, P.ssd_norm);
    for (int g = 0; g < 4; ++g) cvt_job<MAP_NAT>(C, P.pool_w + (size_t)g * 16384, 128, 128, 0, 128, (bf16_t*)(P.ws + WS_WPOOL) + (size_t)g * 16384, 0);
    {
        GAS u32x4* z = (GAS u32x4*)(WS + WO_SIN + (size_t)5152 * 1024); const int n16 = 224 * 1024 * 2 / 16;
        for (int i = blockIdx.x * NTHR + C.tid; i < n16; i += C.G * NTHR) z[i] = (u32x4){0u, 0u, 0u, 0u};
    }
    {
        float* rope = (float*)(P.ws + WS_ROPE);
        for (int i = blockIdx.x * NTHR + C.tid; i < SEQ * 32; i += C.G * NTHR) { const int s = i >> 5, d = i & 31;
            const float inv = exp2f(-(float)d * (13.287712379549449f / 32.f)); const float ang = (float)P.pos[s] * inv;
            float sn, cs; sincosf(ang, &sn, &cs); rope[s * 64 + d] = cs; rope[s * 64 + 32 + d] = sn; }
    }
    bf16_t* hnA = (bf16_t*)(P.ws + WS_HNA); unsigned char* memn = P.ws + WS_MEMN;
    for (int m = C.gw; m < NTOK; m += 4 * C.NGW) rms_rows_to_bf16<4>(P.x, P.mix_norm, hnA, m, C.NGW, C.lane);
    for (int m = C.gw; m < 2 * NBATCH * NMEM; m += C.NGW) { const int l = m >> 11, r = m & 2047;
        if (XA_FP8) rms_row_to_fp8(P.mem + (size_t)r * DM, P.mem_norm + l * DM, memn + (size_t)m * DM, C.lane);
        else rms_row_to_bf16(P.mem + (size_t)r * DM, P.mem_norm + l * DM, (bf16_t*)memn + (size_t)m * DM, C.lane); }
}
template <bool DOWN> DI void moe_weight_cvt(const Params& P, const Ctx& C0) {
    PHASE_CTX(C0);
    unsigned char* WM = P.ws + WS_WMOE8;
    for (int e = 0; e < NEXP; ++e) {
        if constexpr (!DOWN) {
            cvt_job8<MAP_GU_GATE>(C, P.moe_wg + (size_t)e * 1024 * DFE, 1024, DFE, 0, DFE, WM + WM8_GU + (size_t)e * 7168 * 1024);
            cvt_job8<MAP_GU_UP>(C, P.moe_wu + (size_t)e * 1024 * DFE, 1024, DFE, 0, DFE, WM + WM8_GU + (size_t)e * 7168 * 1024);
        } else cvt_job8<MAP_P8>(C, P.moe_wd + (size_t)e * DFE * 1024, DFE, 1024, 0, 1024, WM + WM8_DN + (size_t)e * 1024 * DFE);
    }
}
typedef f32x4 Acc[2][2][4][2];
DI u32x4 pack8(const f32x4& a, const f32x4& b) { u32x4 w; w.x = pk2(a[0], a[1]); w.y = pk2(a[2], a[3]); w.z = pk2(b[0], b[1]); w.w = pk2(b[2], b[3]); return w; }
DI u32x2 pack4(const f32x4& a) { u32x2 w; w.x = pk2(a[0], a[1]); w.y = pk2(a[2], a[3]); return w; }
DI float dot4(const f32x4& a) { return (a[0] * a[0] + a[1] * a[1]) + (a[2] * a[2] + a[3] * a[3]); }
DI float rstd_from_ss(const float* ss, int row, int fq) {
    const f32x4 t = *(const GAS f32x4*)(ss + (size_t)row * 16 + 4 * fq); float s = (t[0] + t[1]) + (t[2] + t[3]);
    s += shx(s, 16); s += shx(s, 32);
    return __builtin_amdgcn_rsqf(s * (1.f / 1024.f) + EPS);
}

DI void rstd8_from_ss(const float* ss, int row0, int wr, int fr, int fq, float (&rs)[2][4]) {
    f32x4 t[2][4];
#pragma unroll
    for (int ai = 0; ai < 2; ++ai)
#pragma unroll
        for (int m = 0; m < 4; ++m) t[ai][m] = *(const GAS f32x4*)(ss + (size_t)(row0 + 128 * ai + 64 * wr + 16 * m + fr) * 16 + 4 * fq);
#pragma unroll
    for (int ai = 0; ai < 2; ++ai)
#pragma unroll
        for (int m = 0; m < 4; ++m) { float s = (t[ai][m][0] + t[ai][m][1]) + (t[ai][m][2] + t[ai][m][3]); s += shx(s, 16); s += shx(s, 32); rs[ai][m] = __builtin_amdgcn_rsqf(s * (1.f / 1024.f) + EPS); }
}
DI void rows8_from_tab(const float* tab, int row0, int wr, int fr, float (&rs)[2][4]) {
#pragma unroll
    for (int ai = 0; ai < 2; ++ai)
#pragma unroll
        for (int m = 0; m < 4; ++m) rs[ai][m] = tab[row0 + 128 * ai + 64 * wr + 16 * m + fr];
}

struct EpiHyIn {
    bf16_t* Q; bf16_t* Kb; bf16_t* U; bf16_t* VT; const float* qg; const float* kg; const float* rope; float* kmp;
    DI void operator()(Acc& acc, const pg8::Unit& u, int wr, int wc, int fr, int fq) const {
        if (u.kind <= 1) {
            const float* gain = u.kind == 0 ? qg : kg; bf16_t* dst = u.kind == 0 ? Q : Kb; const float osc = u.kind == 0 ? 0.125f * 1.4426950408889634f : 1.f;
            f32x4 gv[2][2];
#pragma unroll
            for (int bj = 0; bj < 2; ++bj)
#pragma unroll
                for (int n = 0; n < 2; ++n) gv[bj][n] = *(const GAS f32x4*)(gain + 32 * bj + 8 * fq + 4 * n);
            f32x4 ks[2][2];
#pragma unroll
            for (int bj = 0; bj < 2; ++bj)
#pragma unroll
                for (int n = 0; n < 2; ++n) ks[bj][n] = (f32x4){0.f, 0.f, 0.f, 0.f};
            const int head = 4 * u.aux + wc;
#pragma unroll
            for (int ai = 0; ai < 2; ++ai)
#pragma unroll
                for (int m = 0; m < 4; ++m) {
                    const int row = u.pm * 256 + 128 * ai + 64 * wr + 16 * m + fr;
                    float s = 0.f;
#pragma unroll
                    for (int bj = 0; bj < 2; ++bj)
#pragma unroll
                        for (int n = 0; n < 2; ++n) s += dot4(acc[ai][bj][m][n]);
                    s += shx(s, 16); s += shx(s, 32);
                    const float r = __builtin_amdgcn_rsqf(s * (1.f / 64.f) + EPS);
                    const float* rp = rope + (size_t)(row & (SEQ - 1)) * 64 + 8 * fq;
                    f32x4 o[2][2];
#pragma unroll
                    for (int n = 0; n < 2; ++n) {
                        const f32x4 c4 = *(const GAS f32x4*)(rp + 4 * n), s4 = *(const GAS f32x4*)(rp + 32 + 4 * n);
                        const f32x4 x1 = acc[ai][0][m][n] * r * gv[0][n], x2 = acc[ai][1][m][n] * r * gv[1][n];
                        o[0][n] = (x1 * c4 - x2 * s4) * osc; o[1][n] = (x2 * c4 + x1 * s4) * osc;
                        ks[0][n] += o[0][n]; ks[1][n] += o[1][n];
                    }
#pragma unroll
                    for (int bj = 0; bj < 2; ++bj) *(GAS u32x4*)(dst + (size_t)row * 512 + head * 64 + 32 * bj + 8 * fq) = pack8(o[bj][0], o[bj][1]);
                }
            if (u.kind == 1) {
#pragma unroll
                for (int bj = 0; bj < 2; ++bj)
#pragma unroll
                    for (int n = 0; n < 2; ++n) {
                        f32x4 v = ks[bj][n];
#pragma unroll
                        for (int o = 1; o < 16; o <<= 1) { v[0] += shx(v[0], o); v[1] += shx(v[1], o); v[2] += shx(v[2], o); v[3] += shx(v[3], o); }
                        if (fr == 0) *(GAS f32x4*)(kmp + (size_t)(u.pm * 2 + wr) * 512 + head * 64 + 32 * bj + 8 * fq + 4 * n) = v;
                    }
            }
        } else if (u.kind == 2) {
#pragma unroll
            for (int ai = 0; ai < 2; ++ai)
#pragma unroll
                for (int m = 0; m < 4; ++m) { const int row = u.pm * 256 + 128 * ai + 64 * wr + 16 * m + fr;
#pragma unroll
                    for (int bj = 0; bj < 2; ++bj) *(GAS u32x4*)(U + (size_t)row * 512 + u.aux * 256 + 128 * bj + 32 * wc + 8 * fq) = pack8(acc[ai][bj][m][0], acc[ai][bj][m][1]); }
        } else {
#pragma unroll
            for (int ai = 0; ai < 2; ++ai)
#pragma unroll
                for (int m = 0; m < 4; ++m) { const int feat = u.pm * 256 + 128 * ai + 64 * wr + 16 * m + fr;
#pragma unroll
                    for (int bj = 0; bj < 2; ++bj)
#pragma unroll
                        for (int n = 0; n < 2; ++n) *(GAS u32x2*)(VT + (size_t)feat * NTOK + u.pn * 256 + 128 * bj + 32 * wc + 16 * n + 4 * fq) = pack4(acc[ai][bj][m][n]); }
        }
    }
};
struct SchedHyIn {
    static constexpr bool VAR_K = false;
    const char* hn; const char* wqku; const char* wv; int G, c;
    DI bool next(int i, pg8::Unit& u) const {
        const int L = i * G + c; if (L >= 1024) return false;
        if (L < 768) { int pm, pn; pg8::tile_of(L, 128, 6, pm, pn); u.A = hn + (size_t)pm * 256 * 2048; u.B = wqku + (size_t)pn * 256 * 2048; u.pm = pm; u.pn = pn; u.kind = pn >> 1; u.aux = pn & 1; }
        else { int pm, pn; pg8::tile_of(L - 768, 2, 128, pm, pn); u.A = wv + (size_t)pm * 256 * 2048; u.B = hn + (size_t)pn * 256 * 2048; u.pm = pm; u.pn = pn; u.kind = 3; u.aux = 0; }
        return true;
    }
};

DI unsigned char* res_at(float* out, int row, int pn) { return (unsigned char*)out + (size_t)row * 4096 + pn * 1024; }
DI void unpack8(const u32x4& b, f32x4& lo, f32x4& hi) { lo = (f32x4){bflo(b.x), bfhi(b.x), bflo(b.y), bfhi(b.y)}; hi = (f32x4){bflo(b.z), bfhi(b.z), bflo(b.w), bfhi(b.w)}; }
template <bool F8, bool BASEX = false> struct EpiRes {
    const float* base; float* out; void* hAv; const float* gain; float* ss; float asc;
    DI void operator()(Acc& acc, const pg8::Unit& u, int wr, int wc, int fr, int fq) const {
        const int cl = 32 * wc + 8 * fq;
        f32x4 gv[2][2];
#pragma unroll
        for (int bj = 0; bj < 2; ++bj)
#pragma unroll
            for (int n = 0; n < 2; ++n) gv[bj][n] = *(const GAS f32x4*)(gain + u.pn * 256 + 128 * bj + cl + 4 * n);
        u32x4 bb[BASEX ? 1 : 2][BASEX ? 1 : 4][2];
        if constexpr (!BASEX) {
#pragma unroll
            for (int ai = 0; ai < 2; ++ai)
#pragma unroll
                for (int m = 0; m < 4; ++m)
#pragma unroll
                    for (int bj = 0; bj < 2; ++bj) bb[ai][m][bj] = *(const GAS u32x4*)(res_at(out, u.pm * 256 + 128 * ai + 64 * wr + 16 * m + fr, u.pn) + (128 * bj + cl) * 2);
        }
#pragma unroll
        for (int ai = 0; ai < 2; ++ai) {
            f32x4 bx[BASEX ? 4 : 1][2][2];
            if constexpr (BASEX) {
#pragma unroll
                for (int m = 0; m < 4; ++m)
#pragma unroll
                    for (int bj = 0; bj < 2; ++bj)
#pragma unroll
                        for (int n = 0; n < 2; ++n) bx[m][bj][n] = *(const GAS f32x4*)(base + (size_t)(u.pm * 256 + 128 * ai + 64 * wr + 16 * m + fr) * DM + u.pn * 256 + 128 * bj + cl + 4 * n);
            }
#pragma unroll
            for (int m = 0; m < 4; ++m) {
                const int row = u.pm * 256 + 128 * ai + 64 * wr + 16 * m + fr; float s = 0.f;
#pragma unroll
                for (int bj = 0; bj < 2; ++bj) {
                    f32x4 h0, h1;
                    if constexpr (BASEX) { h0 = bx[m][bj][0]; h1 = bx[m][bj][1]; } else unpack8(bb[ai][m][bj], h0, h1);
                    h0 += acc[ai][bj][m][0] * asc; h1 += acc[ai][bj][m][1] * asc;
                    *(GAS u32x4*)(res_at(out, row, u.pn) + (128 * bj + cl) * 2) = pack8(h0, h1); s += dot4(h0) + dot4(h1);
                    const size_t o = (size_t)row * DM + u.pn * 256 + 128 * bj + cl; const f32x4 g0 = gv[bj][0], g1 = gv[bj][1];
                    if constexpr (F8) { u32x2 w; w.x = pk4_fp8(h0[0] * g0[0], h0[1] * g0[1], h0[2] * g0[2], h0[3] * g0[3]); w.y = pk4_fp8(h1[0] * g1[0], h1[1] * g1[1], h1[2] * g1[2], h1[3] * g1[3]); *(GAS u32x2*)((unsigned char*)hAv + o) = w; }
                    else *(GAS u32x4*)((bf16_t*)hAv + o) = pack8(h0 * g0, h1 * g1);
                }
                s += shx(s, 16); s += shx(s, 32);
                if (fq == 0) ss[(size_t)row * 16 + u.pn * 4 + wc] = s;
            }
            asm volatile("" ::: "memory");
        }
    }
};
struct EpiResRt {
    const float* base; float* out; void* hAv; const float* gain; float* ss; float asc; const float* router; float* lp;
    DI void operator()(Acc& acc, const pg8::Unit& u, int wr, int wc, int fr, int fq) const {
        float sq[2][4];
#pragma unroll
        for (int ai = 0; ai < 2; ++ai)
#pragma unroll
            for (int m = 0; m < 4; ++m) sq[ai][m] = 0.f;
#pragma unroll
        for (int bj = 0; bj < 2; ++bj) {
            const int cl = 128 * bj + 32 * wc + 8 * fq, col0 = u.pn * 256 + cl;
            f32x4 gv[2];
#pragma unroll
            for (int n = 0; n < 2; ++n) gv[n] = *(const GAS f32x4*)(gain + col0 + 4 * n);
            bf16x8 wh, wl;
            { float w[8];
#pragma unroll
              for (int q = 0; q < 8; ++q) w[q] = router[(size_t)(col0 + q) * 8 + (fr & 7)] * gv[q >> 2][q & 3];
              u32x4 hi, lo; hi.x = pk2(w[0], w[1]); hi.y = pk2(w[2], w[3]); hi.z = pk2(w[4], w[5]); hi.w = pk2(w[6], w[7]);
              lo.x = pk2(w[0] - bflo(hi.x), w[1] - bfhi(hi.x)); lo.y = pk2(w[2] - bflo(hi.y), w[3] - bfhi(hi.y)); lo.z = pk2(w[4] - bflo(hi.z), w[5] - bfhi(hi.z)); lo.w = pk2(w[6] - bflo(hi.w), w[7] - bfhi(hi.w));
              wh = __builtin_bit_cast(bf16x8, hi); wl = __builtin_bit_cast(bf16x8, lo); }
#pragma unroll
            for (int am = 0; am < 4; ++am) { const int ai = am >> 1;
                u32x4 bb[4];
#pragma unroll
                for (int m = 2 * (am & 1); m < 2 * (am & 1) + 2; ++m) bb[m] = *(const GAS u32x4*)(res_at(out, u.pm * 256 + 128 * ai + 64 * wr + 16 * m + fr, u.pn) + cl * 2);
#pragma unroll
                for (int m = 2 * (am & 1); m < 2 * (am & 1) + 2; ++m) {
                    const int row = u.pm * 256 + 128 * ai + 64 * wr + 16 * m + fr;
                    f32x4 h[2]; unpack8(bb[m], h[0], h[1]);
                    h[0] += acc[ai][bj][m][0] * asc; h[1] += acc[ai][bj][m][1] * asc;
                    *(GAS u32x4*)(res_at(out, row, u.pn) + cl * 2) = pack8(h[0], h[1]); sq[ai][m] += dot4(h[0]) + dot4(h[1]);
                    { u32x2 w; w.x = pk4_fp8(h[0][0] * gv[0][0], h[0][1] * gv[0][1], h[0][2] * gv[0][2], h[0][3] * gv[0][3]); w.y = pk4_fp8(h[1][0] * gv[1][0], h[1][1] * gv[1][1], h[1][2] * gv[1][2], h[1][3] * gv[1][3]);
                      *(GAS u32x2*)((unsigned char*)hAv + (size_t)row * DM + col0) = w; }
                    u32x4 bh, bl; bh.x = pk2(h[0][0], h[0][1]); bh.y = pk2(h[0][2], h[0][3]); bh.z = pk2(h[1][0], h[1][1]); bh.w = pk2(h[1][2], h[1][3]);
                    bl.x = pk2(h[0][0] - bflo(bh.x), h[0][1] - bfhi(bh.x)); bl.y = pk2(h[0][2] - bflo(bh.y), h[0][3] - bfhi(bh.y)); bl.z = pk2(h[1][0] - bflo(bh.z), h[1][1] - bfhi(bh.z)); bl.w = pk2(h[1][2] - bflo(bh.w), h[1][3] - bfhi(bh.w));
                    f32x4 D = {0.f, 0.f, 0.f, 0.f};
                    D = __builtin_amdgcn_mfma_f32_16x16x32_bf16(wh, __builtin_bit_cast(bf16x8, bh), D, 0, 0, 0);
                    D = __builtin_amdgcn_mfma_f32_16x16x32_bf16(wh, __builtin_bit_cast(bf16x8, bl), D, 0, 0, 0);
                    D = __builtin_amdgcn_mfma_f32_16x16x32_bf16(wl, __builtin_bit_cast(bf16x8, bh), D, 0, 0, 0);
                    *(GAS f32x4*)(lp + ((size_t)row * 32 + (u.pn * 4 + wc) * 2 + bj) * 8 + 4 * (fq & 1)) = D;
                }
                asm volatile("" ::: "memory");
            }
        }
#pragma unroll
        for (int ai = 0; ai < 2; ++ai)
#pragma unroll
            for (int m = 0; m < 4; ++m) { float s = sq[ai][m]; s += shx(s, 16); s += shx(s, 32);
                if (fq == 0) ss[(size_t)(u.pm * 256 + 128 * ai + 64 * wr + 16 * m + fr) * 16 + u.pn * 4 + wc] = s; }
    }
};
struct EpiResSeg {
    const float* base; float* out; void* hAv; const float* gain; float* ss; const float* yss; LAS float* tab;
    DI LAS float* seg_tab(int buf) const { return tab + buf * 1024; }
    DI void seg_prepare(const pg8::Unit& u, int buf, int tid) const {
        if (tid < 256) { const float* yp = yss + (size_t)(u.pm * 256 + tid) * 64; float rs[4];
#pragma unroll
            for (int g = 0; g < 4; ++g) { float a = 0.f;
#pragma unroll
                for (int q = 0; q < 4; ++q) { const f32x4 t = *(const GAS f32x4*)(yp + 16 * g + 4 * q); a += (t[0] + t[1]) + (t[2] + t[3]); }
                rs[g] = __builtin_amdgcn_rsqf(a * (1.f / 512.f) + EPS); }
            *(LAS f32x4*)(seg_tab(buf) + tid * 4) = (f32x4){rs[0] / rs[1], rs[1] / rs[2], rs[2] / rs[3], rs[3]}; }
    }
    DI void operator()(Acc& acc, const pg8::Unit& u, int wr, int wc, int fr, int fq, int buf) const {
        const LAS float* tb = seg_tab(buf) + 3;
        const int cl = 32 * wc + 8 * fq;
        f32x4 gv[2][2];
#pragma unroll
        for (int bj = 0; bj < 2; ++bj)
#pragma unroll
            for (int n = 0; n < 2; ++n) gv[bj][n] = *(const GAS f32x4*)(gain + u.pn * 256 + 128 * bj + cl + 4 * n);
        u32x4 bb[2][4][2];
#pragma unroll
        for (int ai = 0; ai < 2; ++ai)
#pragma unroll
            for (int m = 0; m < 4; ++m)
#pragma unroll
                for (int bj = 0; bj < 2; ++bj) bb[ai][m][bj] = *(const GAS u32x4*)(res_at(out, u.pm * 256 + 128 * ai + 64 * wr + 16 * m + fr, u.pn) + (128 * bj + cl) * 2);
#pragma unroll
        for (int ai = 0; ai < 2; ++ai) {
#pragma unroll
            for (int m = 0; m < 4; ++m) {
                const int rt = 128 * ai + 64 * wr + 16 * m + fr, row = u.pm * 256 + rt; float s = 0.f; const float asc = tb[rt * 4];
#pragma unroll
                for (int bj = 0; bj < 2; ++bj) {
                    f32x4 h0, h1; unpack8(bb[ai][m][bj], h0, h1);
                    h0 += acc[ai][bj][m][0] * asc; h1 += acc[ai][bj][m][1] * asc;
                    *(GAS u32x4*)(res_at(out, row, u.pn) + (128 * bj + cl) * 2) = pack8(h0, h1); s += dot4(h0) + dot4(h1);
                    const size_t o = (size_t)row * DM + u.pn * 256 + 128 * bj + cl; const f32x4 g0 = gv[bj][0], g1 = gv[bj][1];
                    if constexpr (XA_FP8 != 0) { u32x2 w; w.x = pk4_fp8(h0[0] * g0[0], h0[1] * g0[1], h0[2] * g0[2], h0[3] * g0[3]); w.y = pk4_fp8(h1[0] * g1[0], h1[1] * g1[1], h1[2] * g1[2], h1[3] * g1[3]); *(GAS u32x2*)((unsigned char*)hAv + o) = w; }
                    else *(GAS u32x4*)((bf16_t*)hAv + o) = pack8(h0 * g0, h1 * g1);
                }
                s += shx(s, 16); s += shx(s, 32);
                if (fq == 0) ss[(size_t)row * 16 + u.pn * 4 + wc] = s;
            }
            asm volatile("" ::: "memory");
        }
    }
};
struct SchedPlain {
    static constexpr bool VAR_K = false;
    const char* A; const char* B; int nM, nN, lda_b, ldb_b, G, c;
    DI bool next(int i, pg8::Unit& u) const {
        const int L = i * G + c; if (L >= nM * nN) return false;
        int pm, pn; pg8::tile_of(L, nM, nN, pm, pn); u.A = A + (size_t)pm * 256 * lda_b; u.B = B + (size_t)pn * 256 * ldb_b; u.pm = pm; u.pn = pn; u.kind = 0; u.aux = 0; return true;
    }
};

struct EpiXaProj {
    bf16_t* Qx; bf16_t* Kx; bf16_t* VTx; const float* qg; const float* kg; const float* ss; LAS float* XS;
    DI void operator()(Acc& acc, const pg8::Unit& u, int wr, int wc, int fr, int fq) const {
        if (u.kind == 2) {
            bf16_t* vt = VTx + (size_t)u.aux * 1024 * 2048;
#pragma unroll
            for (int ai = 0; ai < 2; ++ai)
#pragma unroll
                for (int m = 0; m < 4; ++m) { const int feat = u.pm * 256 + 128 * ai + 64 * wr + 16 * m + fr;
#pragma unroll
                    for (int bj = 0; bj < 2; ++bj)
#pragma unroll
                        for (int n = 0; n < 2; ++n) *(GAS u32x2*)(vt + (size_t)feat * 2048 + u.pn * 256 + 128 * bj + 32 * wc + 16 * n + 4 * fq) = pack4(acc[ai][bj][m][n] * (1.f / XAWS)); }
            return;
        }
        const float* gain = u.kind == 0 ? qg : kg + u.aux * 256;
        bf16_t* dst = u.kind == 0 ? Qx : Kx + (size_t)u.aux * 2048 * 1024;
        const float osc = u.kind == 0 ? 0.0625f : 1.f;
        float rs8[2][4];
        if (u.kind == 0) rstd8_from_ss(ss, u.pm * 256, wr, fr, fq, rs8);
#pragma unroll
        for (int ai = 0; ai < 2; ++ai)
#pragma unroll
            for (int m = 0; m < 4; ++m) {
                const int rt = 128 * ai + 64 * wr + 16 * m + fr;
                float rs = 1.f / XAWS; if (u.kind == 0) rs *= rs8[ai][m];
                float s = 0.f;
#pragma unroll
                for (int bj = 0; bj < 2; ++bj)
#pragma unroll
                    for (int n = 0; n < 2; ++n) { acc[ai][bj][m][n] *= rs; s += dot4(acc[ai][bj][m][n]); }
                s += shx(s, 16); s += shx(s, 32);
                if (fq == 0) XS[rt * 4 + wc] = s;
            }
        LDS_WAIT(); __builtin_amdgcn_s_barrier(); asm volatile("" ::: "memory");
        f32x4 gv[2][2];
#pragma unroll
        for (int bj = 0; bj < 2; ++bj)
#pragma unroll
            for (int n = 0; n < 2; ++n) gv[bj][n] = *(const GAS f32x4*)(gain + 128 * bj + 32 * wc + 8 * fq + 4 * n);
#pragma unroll
        for (int ai = 0; ai < 2; ++ai)
#pragma unroll
            for (int m = 0; m < 4; ++m) {
                const int rt = 128 * ai + 64 * wr + 16 * m + fr;
                const f32x4 t = *(const LAS f32x4*)(XS + rt * 4);
                const float r = __builtin_amdgcn_rsqf(((t[0] + t[1]) + (t[2] + t[3])) * (1.f / 256.f) + EPS) * osc;
#pragma unroll
                for (int bj = 0; bj < 2; ++bj)
                    *(GAS u32x4*)(dst + (size_t)(u.pm * 256 + rt) * DM + u.pn * 256 + 128 * bj + 32 * wc + 8 * fq) = pack8(acc[ai][bj][m][0] * r * gv[bj][0], acc[ai][bj][m][1] * r * gv[bj][1]);
            }
        LDS_WAIT();
    }
};
struct SchedXaProj {
    static constexpr bool VAR_K = false;
    const char* hA; const char* wq; const char* memn; const char* wk; const char* wv; int lq, l0, l1, G, c;
    DI bool next(int i, pg8::Unit& u) const {
        int L = i * G + c; const int ntot = 512 + (l1 - l0) * 64; if (L >= ntot) return false;
        if (L < 512) { int pm, pn; pg8::tile_of(L, 128, 4, pm, pn); u.A = hA + (size_t)pm * 256 * 1024 * XAB; u.B = wq + (size_t)pn * 256 * 1024 * XAB; u.pm = pm; u.pn = pn; u.kind = 0; u.aux = 0; return true; }
        L -= 512; const int l = l0 + L / 64; L %= 64;
        if (L < 32) { const int pm = L >> 2, pn = L & 3; u.A = memn + ((size_t)l * 2048 * 1024 + (size_t)pm * 256 * 1024) * XAB; u.B = wk + ((size_t)l * 1024 * 1024 + (size_t)pn * 256 * 1024) * XAB; u.pm = pm; u.pn = pn; u.kind = 1; u.aux = l; }
        else { L -= 32; const int pm = L >> 3, pn = L & 7; u.A = wv + ((size_t)l * 1024 * 1024 + (size_t)pm * 256 * 1024) * XAB; u.B = memn + ((size_t)l * 2048 * 1024 + (size_t)pn * 256 * 1024) * XAB; u.pm = pm; u.pn = pn; u.kind = 2; u.aux = l; }
        return true;
    }
};

struct EpiXaS {
    bf16_t* Px; float* psum;
    DI void operator()(Acc& acc, const pg8::Unit& u, int wr, int wc, int fr, int fq) const {
#pragma unroll
        for (int ai = 0; ai < 2; ++ai)
#pragma unroll
            for (int m = 0; m < 4; ++m) {
                const int row = u.pm * 256 + 128 * ai + 64 * wr + 16 * m + fr; float s = 0.f;
#pragma unroll
                for (int bj = 0; bj < 2; ++bj) {
                    f32x4 p0, p1;
#pragma unroll
                    for (int j = 0; j < 4; ++j) { p0[j] = __expf(fminf(acc[ai][bj][m][0][j], 80.f)); p1[j] = __expf(fminf(acc[ai][bj][m][1][j], 80.f)); }
                    s += (p0[0] + p0[1]) + (p0[2] + p0[3]) + (p1[0] + p1[1]) + (p1[2] + p1[3]);
                    *(GAS u32x4*)(Px + (size_t)row * DM + u.pn * 256 + 128 * bj + 32 * wc + 8 * fq) = pack8(p0, p1);
                }
                s += shx(s, 16); s += shx(s, 32);
                if (fq == 0) psum[(size_t)row * 16 + u.pn * 4 + wc] = s;
            }
    }
};
struct EpiXaO {
    unsigned char* Ox; const float* psum;
    DI void operator()(Acc& acc, const pg8::Unit& u, int wr, int wc, int fr, int fq) const {
        f32x4 ps[2][4];
#pragma unroll
        for (int ai = 0; ai < 2; ++ai)
#pragma unroll
            for (int m = 0; m < 4; ++m) ps[ai][m] = *(const GAS f32x4*)(psum + (size_t)(u.pm * 256 + 128 * ai + 64 * wr + 16 * m + fr) * 16 + u.pn * 4);
#pragma unroll
        for (int ai = 0; ai < 2; ++ai)
#pragma unroll
            for (int m = 0; m < 4; ++m) {
                const int row = u.pm * 256 + 128 * ai + 64 * wr + 16 * m + fr;
                const f32x4 t = ps[ai][m];
                const float r = 1.f / ((t[0] + t[1]) + (t[2] + t[3]));
#pragma unroll
                for (int bj = 0; bj < 2; ++bj) { const f32x4 a0 = acc[ai][bj][m][0] * r, a1 = acc[ai][bj][m][1] * r;
                    if constexpr (XA_FP8 != 0) { u32x2 w; w.x = pk4_fp8(a0[0], a0[1], a0[2], a0[3]); w.y = pk4_fp8(a1[0], a1[1], a1[2], a1[3]); *(GAS u32x2*)(Ox + (size_t)row * DM + u.pn * 256 + 128 * bj + 32 * wc + 8 * fq) = w; }
                    else *(GAS u32x4*)((bf16_t*)Ox + (size_t)row * DM + u.pn * 256 + 128 * bj + 32 * wc + 8 * fq) = pack8(a0, a1); }
            }
    }
};
struct SchedXaAttn {
    static constexpr bool VAR_K = false;
    const char* A; const char* B; size_t b_batch, b_head; int G, c;
    DI bool next(int i, pg8::Unit& u) const {
        const int L = i * G + c; if (L >= 512) return false;
        int pm, pn; pg8::tile_of(L, 128, 4, pm, pn); u.A = A + (size_t)pm * 256 * 2048 + pn * 512; u.B = B + (size_t)(pm >> 4) * b_batch + (size_t)pn * b_head; u.pm = pm; u.pn = pn; u.kind = 0; u.aux = 0; return true;
    }
};

struct EpiGU {
    bf16_t* H; int ldh; const float* ss; const float* rsd; int row0;
    DI void operator()(Acc& acc, const pg8::Unit& u, int wr, int wc, int fr, int fq) const {
        float rs8[2][4];
        if (ss) rstd8_from_ss(ss, u.pm * 256, wr, fr, fq, rs8); else rows8_from_tab(rsd, u.pm * 256, wr, fr, rs8);
#pragma unroll
        for (int ai = 0; ai < 2; ++ai)
#pragma unroll
            for (int m = 0; m < 4; ++m) {
                const int row = u.pm * 256 + 128 * ai + 64 * wr + 16 * m + fr;
                const float rs = rs8[ai][m]; const float c1 = -rs * 1.4426950408889634f;
                f32x4 h[2];
#pragma unroll
                for (int n = 0; n < 2; ++n)
#pragma unroll
                    for (int j = 0; j < 4; ++j) { const float ag = acc[ai][0][m][n][j]; h[n][j] = (ag * rs) * __builtin_amdgcn_rcpf(1.f + __builtin_amdgcn_exp2f(ag * c1)) * (acc[ai][1][m][n][j] * rs); }
                *(GAS u32x4*)(H + (size_t)(row - row0) * ldh + u.pn * 128 + 32 * wc + 8 * fq) = pack8(h[0], h[1]);
            }
    }
};
struct EpiSsdIn {
    bf16_t* ZX; float* DT; const float* ss; bf16_t* HALO;
    DI void operator()(Acc& acc, const pg8::Unit& u, int wr, int wc, int fr, int fq) const {
        float rs8[2][4];
        rstd8_from_ss(ss, u.pm * 256, wr, fr, fq, rs8);
#pragma unroll
        for (int ai = 0; ai < 2; ++ai)
#pragma unroll
            for (int m = 0; m < 4; ++m) {
                const int row = u.pm * 256 + 128 * ai + 64 * wr + 16 * m + fr;
                const float rs = rs8[ai][m];
                {
#pragma unroll
                    for (int bj = 0; bj < 2; ++bj) { const u32x4 pk = pack8(acc[ai][bj][m][0] * rs, acc[ai][bj][m][1] * rs);
                        *(GAS u32x4*)(ZX + zx_off(row, u.pn * 256 + 128 * bj + 32 * wc + 8 * fq)) = pk;
                        if (u.pn >= 8 && (row & 127) >= 125) *(GAS u32x4*)(HALO + ((size_t)(row >> 7) * 3 + ((row & 127) - 125)) * SSD_XBC + (u.pn - 8) * 256 + 128 * bj + 32 * wc + 8 * fq) = pk; }
                }
            }
    }
};
struct EpiBf16Out {
    bf16_t* O; int ldo; float sc;
    DI void operator()(Acc& acc, const pg8::Unit& u, int wr, int wc, int fr, int fq) const {
#pragma unroll
        for (int ai = 0; ai < 2; ++ai)
#pragma unroll
            for (int m = 0; m < 4; ++m) { const int row = u.pm * 256 + 128 * ai + 64 * wr + 16 * m + fr;
#pragma unroll
                for (int bj = 0; bj < 2; ++bj) *(GAS u32x4*)(O + (size_t)row * ldo + u.pn * 256 + 128 * bj + 32 * wc + 8 * fq) = pack8(acc[ai][bj][m][0] * sc, acc[ai][bj][m][1] * sc); }
    }
};
template <size_t A_BLK, size_t W_EXP, size_t W_TILE, int NN> struct SchedMoe {
    static constexpr bool VAR_K = false;
    const char* A; const char* W; const LAS int* tb; int nb, G, c;
    DI bool next(int i, pg8::Unit& u) const {
        const int L = i * G + c; if (L >= nb * NN) return false;
        int pm, pn; pg8::tile_of(L, nb, NN, pm, pn); const int e = __builtin_amdgcn_readfirstlane(tb[pm]);
        u.A = A + (size_t)pm * A_BLK; u.B = W + (size_t)e * W_EXP + (size_t)pn * W_TILE; u.pm = pm; u.pn = pn; u.kind = 0; u.aux = e; return true;
    }
};
template <size_t A_BLK, size_t W_EXP, size_t W_TILE> struct SchedMoeDn {
    static constexpr bool VAR_K = true;
    const char* A; const char* W; const LAS int* tb; int nb, G, c;
    DI int ktiles(const pg8::Unit& u, int nt) const { return u.kind ? 4 : nt; }
    DI bool next(int i, pg8::Unit& u) const {
        const int L = i * G + c; int pm, pn, s = 0, kind = 0;
        if (L < 1024) pg8::tile_of(L, 256, 4, pm, pn);
        else { const int q = L - 1024; if (q >= (nb - 256) * 28) return false; const int un = q / 7; s = q - un * 7; pm = 256 + (un >> 2); pn = un & 3; kind = 1; }
        const int e = __builtin_amdgcn_readfirstlane(tb[pm]);
        u.A = A + (size_t)pm * A_BLK + s * 512; u.B = W + (size_t)e * W_EXP + (size_t)pn * W_TILE + s * 512; u.pm = pm; u.pn = pn; u.kind = kind; u.aux = s; return true;
    }
};
struct EpiMoeDn {
    bf16_t* O; float* part; float sc;
    DI void operator()(Acc& acc, const pg8::Unit& u, int wr, int wc, int fr, int fq) const {
        if (u.kind == 0) {
            asm volatile("; full-K unit" ::: "memory");
#pragma unroll
            for (int ai = 0; ai < 2; ++ai)
#pragma unroll
                for (int m = 0; m < 4; ++m) { const int row = u.pm * 256 + 128 * ai + 64 * wr + 16 * m + fr;
#pragma unroll
                    for (int bj = 0; bj < 2; ++bj) *(GAS u32x4*)(O + (size_t)row * DM + u.pn * 256 + 128 * bj + 32 * wc + 8 * fq) = pack8(acc[ai][bj][m][0] * sc, acc[ai][bj][m][1] * sc); }
        } else {
            asm volatile("; split-K unit" ::: "memory");
            float* pb = part + (size_t)u.aux * (2048 * 1024) + (size_t)(u.pm - 256) * (256 * 1024) + u.pn * 256;
#pragma unroll
            for (int ai = 0; ai < 2; ++ai)
#pragma unroll
                for (int m = 0; m < 4; ++m) { const int row = 128 * ai + 64 * wr + 16 * m + fr;
#pragma unroll
                    for (int bj = 0; bj < 2; ++bj) { GAS f32x4* d = (GAS f32x4*)(pb + (size_t)row * DM + 128 * bj + 32 * wc + 8 * fq); d[0] = acc[ai][bj][m][0] * sc; d[1] = acc[ai][bj][m][1] * sc; } }
        }
    }
};

struct EpiGU8 {
    unsigned char* H; int ldh; const float* ss; const float* rsd;
    DI void operator()(Acc& acc, const pg8::Unit& u, int wr, int wc, int fr, int fq) const {
        float rs8[2][4];
        if (ss) rstd8_from_ss(ss, u.pm * 256, wr, fr, fq, rs8); else rows8_from_tab(rsd, u.pm * 256, wr, fr, rs8);
#pragma unroll
        for (int ai = 0; ai < 2; ++ai)
#pragma unroll
            for (int m = 0; m < 4; ++m) {
                const int row = u.pm * 256 + 128 * ai + 64 * wr + 16 * m + fr;
                const float rs = rs8[ai][m] * (1.f / MOE_WSCALE), c1 = -rs * 1.4426950408889634f, c2 = rs * MOE_HSCALE;
                f32x4 h[2];
#pragma unroll
                for (int n = 0; n < 2; ++n)
#pragma unroll
                    for (int j = 0; j < 4; ++j) { const float ag = acc[ai][0][m][n][j]; h[n][j] = (ag * rs) * __builtin_amdgcn_rcpf(1.f + __builtin_amdgcn_exp2f(ag * c1)) * (acc[ai][1][m][n][j] * c2); }
                u32x2 w; w.x = pk4_fp8(h[0][0], h[0][1], h[0][2], h[0][3]); w.y = pk4_fp8(h[1][0], h[1][1], h[1][2], h[1][3]);
                *(GAS u32x2*)(H + (size_t)row * ldh + u.pn * 128 + 32 * wc + 8 * fq) = w;
            }
    }
};
DI void moe_router(const Params& P, const Ctx& C0) {
    PHASE_CTX(C0);
    unsigned char* rt = P.ws + WS_ROUTE;
    int* tok_e = (int*)(rt + RT_E); float* tok_g = (float*)(rt + RT_G); int* tok_rank = (int*)(rt + RT_RANK); float* tok_rs = (float*)(rt + RT_RS); int* wg_cnt = (int*)(rt + RT_CNT);
    const float* LP = (const float*)(P.ws + WS_LP); const float* SSp = (const float*)(P.ws + WS_SS);
    LAS int* pe = (LAS int*)(C.lds + 32768);
    const int tpw = NTOK / C.G;
    for (int lt0 = C.wave * 2; lt0 < tpw; lt0 += NWAVES * 2) {
        const int lt = lt0 + (C.lane >> 5), tok = blockIdx.x * tpw + lt, p = C.lane & 31;
        const f32x4 a = *(const GAS f32x4*)(LP + ((size_t)tok * 32 + p) * 8), b = *(const GAS f32x4*)(LP + ((size_t)tok * 32 + p) * 8 + 4);
        float sq = SSp[(size_t)tok * 16 + (p & 15)]; sq = p < 16 ? sq : 0.f; sq = dpp_row_sum(sq); sq += shx(sq, 16);
        float l8[8];
#pragma unroll
        for (int e = 0; e < 4; ++e) { l8[e] = dpp_row_sum(a[e]); l8[e] += shx(l8[e], 16); l8[4 + e] = dpp_row_sum(b[e]); l8[4 + e] += shx(l8[4 + e], 16); }
        const float rs = __builtin_amdgcn_rsqf(sq * (1.f / 1024.f) + EPS);
        int e0 = 0; float b0 = l8[0];
#pragma unroll
        for (int e = 1; e < 8; ++e) if (l8[e] > b0) { b0 = l8[e]; e0 = e; }
        int e1 = -1; float b1 = -INFINITY;
#pragma unroll
        for (int e = 0; e < 8; ++e) if (e != e0 && l8[e] > b1) { b1 = l8[e]; e1 = e; }
        const float g1 = 1.f / (1.f + __expf((b0 - b1) * rs)), g0 = 1.f - g1;
        if (p == 0) { tok_e[tok * 2] = e0; tok_e[tok * 2 + 1] = e1; tok_g[tok * 2] = g0; tok_g[tok * 2 + 1] = g1; tok_rs[tok] = rs; pe[lt * 2] = e0; pe[lt * 2 + 1] = e1; }
    }
    __syncthreads();
    const int npair = 2 * tpw;
    for (int t = C.tid; t < npair; t += NTHR) { const int e = pe[t]; int r = 0; for (int u = 0; u < t; ++u) r += (pe[u] == e); tok_rank[blockIdx.x * npair + t] = r; }
    if (C.tid < 8) { int cnt = 0; for (int u = 0; u < npair; ++u) cnt += (pe[u] == C.tid); wg_cnt[blockIdx.x * 8 + C.tid] = cnt; }
}
DI void moe_scatter(const Params& P, const Ctx& C0) {
    PHASE_CTX(C0);
    unsigned char* rt = P.ws + WS_ROUTE;
    const int* tok_e = (const int*)(rt + RT_E); const int* tok_rank = (const int*)(rt + RT_RANK); const float* tok_rs = (const float*)(rt + RT_RS); const int* wg_cnt = (const int*)(rt + RT_CNT);
    int* tok_dest = (int*)(rt + RT_DEST); int* blke = (int*)(rt + RT_BLKE); float* rsd = (float*)(rt + RT_RSD);
    LAS int* sh = (LAS int*)C.lds;
    __syncthreads();
    for (int i = C.tid; i < C.G * 8; i += NTHR) sh[64 + i] = wg_cnt[i];
    __syncthreads();
    if (C.tid < 8) { int tot = 0, mine = 0; for (int w = 0; w < C.G; ++w) { const int c = sh[64 + w * 8 + C.tid]; if (w < (int)blockIdx.x) mine += c; tot += c; } sh[C.tid] = mine; sh[32 + C.tid] = (tot + 255) & ~255; }
    __syncthreads();
    if (C.tid == 0) { int acc = 0; for (int e = 0; e < 8; ++e) { sh[8 + e] = acc; acc += sh[32 + e]; sh[16 + e] = acc; } }
    __syncthreads();
    if (blockIdx.x == 0) { for (int blk = C.tid; blk < 264; blk += NTHR) { int e = 0; for (int k = 0; k < 8; ++k) e += (blk * 256 >= sh[16 + k]); blke[blk] = e < 7 ? e : 7; } if (C.tid == 0) blke[264] = sh[16 + 7] >> 8; }
    const int tpw = NTOK / C.G, npair = 2 * tpw;
    const unsigned char* hA = P.ws + WS_HNA3; unsigned char* X = P.ws + WS_XBUF8;
    for (int t0 = C.wave * 8; t0 < npair; t0 += NWAVES * 8) {
        u32x4 rowv[8]; int dst[8];
#pragma unroll
        for (int k = 0; k < 8; ++k) { const int pidx = blockIdx.x * npair + t0 + k, tok = pidx >> 1; const int e = tok_e[pidx]; dst[k] = sh[8 + e] + sh[e] + tok_rank[pidx];
            rowv[k] = ((const GAS u32x4*)(hA + (size_t)tok * DM))[C.lane]; }
#pragma unroll
        for (int k = 0; k < 8; ++k) { const int pidx = blockIdx.x * npair + t0 + k, tok = pidx >> 1;
            ((GAS u32x4*)(X + (size_t)dst[k] * DM))[C.lane] = rowv[k];
            if (C.lane == 0) { tok_dest[pidx] = dst[k]; rsd[dst[k]] = tok_rs[tok]; } }
    }
}
DI void moe_combine(const Params& P, const Ctx& C0) {
    PHASE_CTX(C0);
    unsigned char* rt = P.ws + WS_ROUTE; const float* tok_g = (const float*)(rt + RT_G); const int* tok_dest = (const int*)(rt + RT_DEST);
    const bf16_t* Yb = (const bf16_t*)(P.ws + WS_YBUF); const float* PART = (const float*)(P.ws + WS_XBUF8);
    for (int tok0 = C.gw; tok0 < NTOK; tok0 += 2 * C.NGW) {
        u32x2 hv[2][4], ya[2][4], yb[2][4]; float g0[2], g1[2];
#pragma unroll
        for (int t = 0; t < 2; ++t) { const int tok = tok0 + t * C.NGW; const int d0 = __builtin_amdgcn_readfirstlane(tok_dest[tok * 2]), d1 = __builtin_amdgcn_readfirstlane(tok_dest[tok * 2 + 1]); g0[t] = tok_g[tok * 2]; g1[t] = tok_g[tok * 2 + 1];
            const GAS unsigned char* o = (const GAS unsigned char*)P.out + (size_t)tok * 4096; const GAS u32x2* y0 = (const GAS u32x2*)(Yb + (size_t)d0 * DM); const GAS u32x2* y1 = (const GAS u32x2*)(Yb + (size_t)d1 * DM);
#pragma unroll
            for (int j = 0; j < 4; ++j) { const int i = 64 * j + C.lane; hv[t][j] = *(const GAS u32x2*)(o + 1024 * j + 8 * C.lane); ya[t][j] = y0[i]; yb[t][j] = y1[i]; }
            if (d0 >= 65536) { asm volatile("; split-K row" ::: "memory");
#pragma unroll
                for (int j = 0; j < 4; ++j) { f32x4 a = {0.f, 0.f, 0.f, 0.f}; for (int s = 0; s < 7; ++s) a += ((const GAS f32x4*)(PART + ((size_t)s * 2048 + (d0 - 65536)) * DM))[64 * j + C.lane]; u32x2 w; w.x = pk2(a[0], a[1]); w.y = pk2(a[2], a[3]); ya[t][j] = w; } }
            if (d1 >= 65536) { asm volatile("; split-K row" ::: "memory");
#pragma unroll
                for (int j = 0; j < 4; ++j) { f32x4 a = {0.f, 0.f, 0.f, 0.f}; for (int s = 0; s < 7; ++s) a += ((const GAS f32x4*)(PART + ((size_t)s * 2048 + (d1 - 65536)) * DM))[64 * j + C.lane]; u32x2 w; w.x = pk2(a[0], a[1]); w.y = pk2(a[2], a[3]); yb[t][j] = w; } } }
#pragma unroll
        for (int t = 0; t < 2; ++t) { const int tok = tok0 + t * C.NGW; GAS f32x4* o = (GAS f32x4*)(P.out + (size_t)tok * DM);
#pragma unroll
            for (int j = 0; j < 4; ++j) { const u32x2 hb = hv[t][j]; f32x4 v = {bflo(hb.x), bfhi(hb.x), bflo(hb.y), bfhi(hb.y)}; const u32x2 a = ya[t][j], b = yb[t][j];
                v[0] += g0[t] * bflo(a.x) + g1[t] * bflo(b.x); v[1] += g0[t] * bfhi(a.x) + g1[t] * bfhi(b.x); v[2] += g0[t] * bflo(a.y) + g1[t] * bflo(b.y); v[3] += g0[t] * bfhi(a.y) + g1[t] * bfhi(b.y); o[64 * j + C.lane] = v; } }
    }
}
typedef __bf16 bf16x2_t __attribute__((ext_vector_type(2)));
DI unsigned cvtpk(float lo, float hi) { f32x2 v = {lo, hi}; bf16x2_t b = __builtin_convertvector(v, bf16x2_t); return __builtin_bit_cast(unsigned, b); }
DI void moba_mfma(const Params& P, const Ctx& C0) {
    PHASE_CTX(C0);
    const int lane = C.lane, w = C.wave, r = lane & 31, hh = lane >> 5;
    const bf16_t* Qg = (const bf16_t*)(P.ws + WS_QKU); const bf16_t* Kg = Qg + (size_t)NTOK * 512; const bf16_t* VTg = (const bf16_t*)(P.ws + WS_VT);
    const float* kmp = (const float*)(P.ws + WS_KMP); bf16_t* AP = (bf16_t*)(P.ws + WS_AP);
    LAS unsigned char* KB = C.lds; LAS unsigned char* VB = C.lds + 65536; LAS float* KM = (LAS float*)(C.lds + XS_OFF);
    const int pr = (r & 16) + ((r >> 2) & 1) * 8 + ((r >> 3) & 1) * 4 + (r & 3);
    for (int it = blockIdx.x; it < 512; it += C.G) {
        const int xcd = it & 7, slot = it >> 3, pp = slot & 7, bh = xcd * 8 + (slot >> 3), b = bh >> 3, h = bh & 7;
        for (int half = 0; half < 2; ++half) {
            const int own = half == 0 ? pp : 15 - pp;
            const int row0 = b * SEQ + own * 256;
            for (int i = C.tid; i < 16 * 64; i += NTHR) { const int j = i >> 6, d = i & 63; float v = 0.f;
                if (j < own) { const float* k0 = kmp + (size_t)((b * 16 + j) * 2) * 512 + h * 64 + d; v = k0[0] + k0[512]; } KM[i] = v; }
            LDS_WAIT(); __builtin_amdgcn_s_barrier(); asm volatile("" ::: "memory");
#define MOBA_DMA(j) do { const int bf_ = (j) & 1; _Pragma("unroll") for (int q_ = 0; q_ < 4; ++q_) { const int q = 4 * w + q_; \
                { const int row = 8 * q + (lane >> 3), c = (lane & 7) ^ ((row >> 1) & 7); \
                  __builtin_amdgcn_global_load_lds((const unsigned*)(Kg + (size_t)(b * SEQ + (j) * 256 + row) * 512 + h * 64 + c * 8), (LAS unsigned*)(KB + bf_ * 32768 + q * 1024), 16, 0, 0); } \
                { const int row = 2 * q + (lane >> 5), cq = (lane & 31) ^ (row & 15); \
                  __builtin_amdgcn_global_load_lds((const unsigned*)(VTg + (size_t)(h * 64 + row) * NTOK + b * SEQ + (j) * 256 + cq * 8), (LAS unsigned*)(VB + bf_ * 32768 + q * 1024), 16, 0, 0); } } } while (0)
            MOBA_DMA(0);
            bf16x8 qf[4];
#pragma unroll
            for (int s = 0; s < 4; ++s) qf[s] = *(const GAS bf16x8*)(Qg + (size_t)(row0 + 32 * w + r) * 512 + h * 64 + 16 * s + 8 * hh);
            unsigned sel = 0u;
            if (own <= 3) sel = (1u << own) - 1u;
            else {
                float g[15];
#pragma unroll
                for (int j = 0; j < 15; ++j) { float a = 0.f;
                    if (j < own) {
#pragma unroll
                        for (int s = 0; s < 4; ++s) { const f32x4 k0 = *(const LAS f32x4*)(KM + j * 64 + 16 * s + 8 * hh), k1 = *(const LAS f32x4*)(KM + j * 64 + 16 * s + 8 * hh + 4);
#pragma unroll
                            for (int t = 0; t < 4; ++t) { a += bf2f((unsigned short)qf[s][t]) * k0[t]; a += bf2f((unsigned short)qf[s][4 + t]) * k1[t]; } }
                        a += shx(a, 32); }
                    g[j] = a; }
#pragma unroll
                for (int pass = 0; pass < 3; ++pass) { float best = -INFINITY; int bi = 0;
#pragma unroll
                    for (int j = 0; j < 15; ++j) { const bool c = (j < own) && !((sel >> j) & 1u) && (g[j] > best); best = c ? g[j] : best; bi = c ? j : bi; }
                    sel |= 1u << bi; }
            }
            unsigned kofs[4], vofs[4];
#pragma unroll
            for (int s = 0; s < 4; ++s) kofs[s] = pr * 128 + (((2 * s + hh) ^ ((pr >> 1) & 7)) << 4);
#pragma unroll
            for (int q = 0; q < 4; ++q) vofs[q] = r * 512 + (((2 * q + hh) ^ (r & 7)) << 4);
            const unsigned vk0 = (r & 8) << 4, vk1 = 128u - vk0;
            f32x16 O0, O1;
#pragma unroll
            for (int i = 0; i < 16; ++i) { O0[i] = 0.f; O1[i] = 0.f; }
            float l = 0.f;
            const int qi = 32 * w + r;
            for (int j = 0; j <= own; ++j) {
                VM_WAIT(); __builtin_amdgcn_s_barrier(); asm volatile("" ::: "memory");
                if (j < own) MOBA_DMA(j + 1);
                const float bias = (j == own) ? 0.f : (((sel >> j) & 1u) ? 0.f : -INFINITY);
                const LAS unsigned char* kb = KB + (j & 1) * 32768; const LAS unsigned char* vb = VB + (j & 1) * 32768;
#pragma unroll 1
                for (int kt = 0; kt < 4; ++kt) {
                    if (j == own && 64 * kt > 32 * w + 31) break;
                    const bool diag = (j == own) && (64 * kt + 63 > 32 * w);
                    u32x4 pa[2][2];
#pragma unroll
                    for (int mt = 0; mt < 2; ++mt) {
                        f32x16 X;
#pragma unroll
                        for (int i = 0; i < 16; ++i) X[i] = bias;
#pragma unroll
                        for (int s = 0; s < 4; ++s) { const bf16x8 kf = *(const LAS bf16x8*)(kb + (64 * kt + 32 * mt) * 128 + kofs[s]);
                            X = __builtin_amdgcn_mfma_f32_32x32x16_bf16(kf, qf[s], X, 0, 0, 0); }
                        if (diag) {
                            asm volatile("; diagonal tile" ::: "memory");
#pragma unroll
                            for (int i = 0; i < 16; ++i) { const int ki = 64 * kt + 32 * mt + 16 * (i >> 3) + 8 * hh + 4 * ((i >> 2) & 1) + (i & 3); X[i] = (ki <= qi) ? X[i] : -INFINITY; }
                        }
#pragma unroll
                        for (int i = 0; i < 16; ++i) { const float p = __builtin_amdgcn_exp2f(X[i]); X[i] = p; l += p; }
#pragma unroll
                        for (int s2 = 0; s2 < 2; ++s2) { pa[mt][s2].x = cvtpk(X[8 * s2], X[8 * s2 + 1]); pa[mt][s2].y = cvtpk(X[8 * s2 + 2], X[8 * s2 + 3]); pa[mt][s2].z = cvtpk(X[8 * s2 + 4], X[8 * s2 + 5]); pa[mt][s2].w = cvtpk(X[8 * s2 + 6], X[8 * s2 + 7]); }
                    }
#pragma unroll
                    for (int mt = 0; mt < 2; ++mt)
#pragma unroll
                        for (int s2 = 0; s2 < 2; ++s2) { const unsigned vo = vofs[2 * mt + s2] + ((kt & 1) ? vk1 : vk0) + 256 * (kt >> 1);
                            const bf16x8 v0 = *(const LAS bf16x8*)(vb + vo), v1 = *(const LAS bf16x8*)(vb + 32 * 512 + vo);
                            const bf16x8 pf = __builtin_bit_cast(bf16x8, pa[mt][s2]);
                            O0 = __builtin_amdgcn_mfma_f32_32x32x16_bf16(pf, v0, O0, 0, 0, 0); O1 = __builtin_amdgcn_mfma_f32_32x32x16_bf16(pf, v1, O1, 0, 0, 0); }
                }
            }
            l += shx(l, 32);
            const float inv = 1.f / l;
#pragma unroll
            for (int i = 0; i < 16; ++i) { const int q = (i & 3) + 8 * (i >> 2) + 4 * hh; const float iv = shl_from(inv, q);
                bf16_t* o = AP + (size_t)(row0 + 32 * w + q) * DM + h * 64 + r;
                o[0] = (bf16_t)f2bf(O0[i] * iv); o[32] = (bf16_t)f2bf(O1[i] * iv); }
        }
    }
    VM_WAIT(); __builtin_amdgcn_s_barrier();
#undef MOBA_DMA
}
DI void pool_mfma(const Params& P, const Ctx& C0) {
    PHASE_CTX(C0);
    const int lane = C.lane, w = C.wave, r = lane & 31, hh = lane >> 5, tid = C.tid;
    const bf16_t* U = (const bf16_t*)(P.ws + WS_QKU) + (size_t)2 * NTOK * 512; bf16_t* AP = (bf16_t*)(P.ws + WS_AP);
    const bf16_t* WP = (const bf16_t*)(P.ws + WS_WPOOL);
    LAS unsigned char* UT = C.lds;
    for (int unit = blockIdx.x; unit < 512; unit += C.G) {
        const int pm = unit >> 2, g = unit < 256 ? (unit & 3) : 3 - (unit & 3), win = 2 << g, row0 = pm * 256;
        __builtin_amdgcn_s_barrier(); asm volatile("" ::: "memory");
        {
            u32x4 v[9];
#pragma unroll
            for (int k = 0; k < 9; ++k) { const int i = tid + NTHR * k, ir = i >> 4, ch = i & 15, grow = row0 - 16 + ir;
                v[k] = (u32x4){0u, 0u, 0u, 0u}; if (i < 272 * 16 && grow >= 0) v[k] = *(const GAS u32x4*)(U + (size_t)grow * 512 + g * 128 + ch * 8); }
#pragma unroll
            for (int k = 0; k < 9; ++k) { const int i = tid + NTHR * k, ir = i >> 4, ch = i & 15;
                if (i < 272 * 16) *(LAS u32x4*)(UT + ir * 256 + ((ch ^ (ir & 15)) << 4)) = v[k]; }
        }
        LDS_WAIT(); __builtin_amdgcn_s_barrier(); asm volatile("" ::: "memory");
        const int lrow = 32 * w + r, ir0 = lrow + 16, s = (row0 + lrow) & (SEQ - 1);
        const int cnt = (s + 1 < win) ? s + 1 : win; const float icnt = 1.f / (float)cnt;
        f32x16 acc[4];
#pragma unroll
        for (int nt = 0; nt < 4; ++nt)
#pragma unroll
            for (int i = 0; i < 16; ++i) acc[nt][i] = 0.f;
#pragma unroll 1
        for (int ks = 0; ks < 8; ++ks) {
            const int ch = 2 * ks + hh;
            float sum[8];
#pragma unroll
            for (int j = 0; j < 8; ++j) sum[j] = 0.f;
            u32x4 self = (u32x4){0u, 0u, 0u, 0u};
            for (int t = 0; t < win; ++t) {
                const int ir = ir0 - t; const u32x4 v = *(const LAS u32x4*)(UT + ir * 256 + ((ch ^ (ir & 15)) << 4));
                if (t == 0) self = v;
                const float m = t < cnt ? 1.f : 0.f;
                sum[0] += m * bflo(v.x); sum[1] += m * bfhi(v.x); sum[2] += m * bflo(v.y); sum[3] += m * bfhi(v.y); sum[4] += m * bflo(v.z); sum[5] += m * bfhi(v.z); sum[6] += m * bflo(v.w); sum[7] += m * bfhi(v.w);
            }
            u32x4 af;
            af.x = cvtpk(sum[0] * icnt - bflo(self.x), sum[1] * icnt - bfhi(self.x)); af.y = cvtpk(sum[2] * icnt - bflo(self.y), sum[3] * icnt - bfhi(self.y));
            af.z = cvtpk(sum[4] * icnt - bflo(self.z), sum[5] * icnt - bfhi(self.z)); af.w = cvtpk(sum[6] * icnt - bflo(self.w), sum[7] * icnt - bfhi(self.w));
            const bf16x8 a8 = __builtin_bit_cast(bf16x8, af);
#pragma unroll
            for (int nt = 0; nt < 4; ++nt) { const bf16x8 b8 = *(const GAS bf16x8*)(WP + (size_t)g * 16384 + (32 * nt + r) * 128 + 16 * ks + 8 * hh);
                acc[nt] = __builtin_amdgcn_mfma_f32_32x32x16_bf16(a8, b8, acc[nt], 0, 0, 0); }
        }
        LAS unsigned char* OT = C.lds + 69632 + w * 8192;
#pragma unroll
        for (int nt = 0; nt < 4; ++nt) { const float sc = P.pool_scale[g * 128 + 32 * nt + r];
#pragma unroll
            for (int i = 0; i < 16; ++i) { const int q = (i & 3) + 8 * (i >> 2) + 4 * hh;
                *(LAS unsigned short*)(OT + q * 256 + (32 * nt + r) * 2) = (unsigned short)f2bf(acc[nt][i] * sc); } }
        LDS_WAIT(); asm volatile("" ::: "memory");
#pragma unroll
        for (int k = 0; k < 8; ++k) { const int pc = lane + 64 * k, orow = pc >> 4, och = pc & 15;
            *(GAS u32x4*)(AP + (size_t)(row0 + 32 * w + orow) * DM + 512 + g * 128 + och * 8) = *(const LAS u32x4*)(OT + orow * 256 + och * 16); }
    }
    __builtin_amdgcn_s_barrier();
}
typedef short v4i16_t __attribute__((ext_vector_type(4)));
DI unsigned off_b(unsigned row, unsigned ch) { return 256u * row + 16u * (ch ^ (((row & 3u) << 2) | ((row >> 2) & 3u))); }
DI void ssd_conv_prepass(const Params& P, const Ctx& C0) {
    PHASE_CTX(C0);
    bf16_t* ZX = (bf16_t*)(P.ws + WS_ZX); const bf16_t* HALO = (const bf16_t*)(P.ws + WS_HALO);
    const bf16_t* hnA = (const bf16_t*)(P.ws + WS_HNA); const bf16_t* Wdt = (const bf16_t*)(P.ws + WS_WSMALL) + WO_SIN + (size_t)5120 * 1024;
    const float* ss = (const float*)(P.ws + WS_SS); float* DTo = (float*)(P.ws + WS_DT);
    LAS float* red = (LAS float*)C.lds;
    LAS float* rsl = (LAS float*)(C.lds + 16384);
    for (int chunk = blockIdx.x; chunk < NTOK / 128; chunk += C.G) {
        const int c = chunk & 31;
        {
            const int lane = C.lane, w = C.wave, r = lane & 31, hh = lane >> 5, rt = w & 3, kh = w >> 2;
            __builtin_amdgcn_s_barrier();
            if (C.tid < 128) { const float* sp = ss + (size_t)(chunk * 128 + C.tid) * 16; float a = 0.f;
#pragma unroll
                for (int q = 0; q < 4; ++q) { const f32x4 t = *(const GAS f32x4*)(sp + 4 * q); a += (t[0] + t[1]) + (t[2] + t[3]); }
                rsl[C.tid] = __builtin_amdgcn_rsqf(a * (1.f / 1024.f) + EPS); }
            f32x16 acc;
#pragma unroll
            for (int i = 0; i < 16; ++i) acc[i] = 0.f;
            const bf16_t* ap = hnA + (size_t)(chunk * 128 + 32 * rt + r) * DM + 512 * kh + 8 * hh; const bf16_t* bp = Wdt + (size_t)r * 1024 + 512 * kh + 8 * hh;
#pragma unroll 8
            for (int ks = 0; ks < 32; ++ks) acc = __builtin_amdgcn_mfma_f32_32x32x16_bf16(*(const GAS bf16x8*)(ap + 16 * ks), *(const GAS bf16x8*)(bp + 16 * ks), acc, 0, 0, 0);
            if (kh == 1) {
#pragma unroll
                for (int i = 0; i < 16; ++i) red[(rt * 16 + i) * 64 + lane] = acc[i]; }
            LDS_WAIT(); __builtin_amdgcn_s_barrier(); asm volatile("" ::: "memory");
            if (kh == 0) {
#pragma unroll
                for (int i = 0; i < 16; ++i) { const int row = 32 * rt + (i & 3) + 8 * (i >> 2) + 4 * hh;
                    DTo[(size_t)(chunk * 128 + row) * 32 + r] = (acc[i] + red[(rt * 16 + i) * 64 + lane]) * rsl[row]; } }
        }
#pragma unroll 1
        for (int k = 0; k < 3; ++k) {
            const int ch = 2 * (C.tid + 512 * k);
            f32x2 cw[4];
#pragma unroll
            for (int i = 0; i < 4; ++i) cw[i] = *(const GAS f32x2*)(P.conv_w + i * SSD_XBC + ch);
            const f32x2 cb = *(const GAS f32x2*)(P.conv_b + ch);
            unsigned r0 = 0u, r1 = 0u, r2 = 0u;
            if (c > 0) { const bf16_t* hp = HALO + (size_t)(chunk - 1) * 3 * SSD_XBC + ch; r0 = *(const GAS unsigned*)hp; r1 = *(const GAS unsigned*)(hp + SSD_XBC); r2 = *(const GAS unsigned*)(hp + 2 * SSD_XBC); }
            GAS unsigned* col = (GAS unsigned*)(ZX + zx_off(chunk * 128, 2048 + ch));
#pragma unroll 1
            for (int t0 = 0; t0 < 128; t0 += 32) {
                unsigned v[32];
#pragma unroll
                for (int j = 0; j < 32; ++j) v[j] = col[(size_t)(t0 + j) * 128];
#pragma unroll
                for (int j = 0; j < 32; ++j) {
                    const float a0 = cb.x + bflo(r0) * cw[0].x + bflo(r1) * cw[1].x + bflo(r2) * cw[2].x + bflo(v[j]) * cw[3].x;
                    const float a1 = cb.y + bfhi(r0) * cw[0].y + bfhi(r1) * cw[1].y + bfhi(r2) * cw[2].y + bfhi(v[j]) * cw[3].y;
                    col[(size_t)(t0 + j) * 128] = pk2(silu_f(a0), silu_f(a1));
                    r0 = r1; r1 = r2; r2 = v[j];
                }
            }
        }
    }
}
DI void ssd_chunked2(const Params& P, const Ctx& C0, bf16_t* Yout, float* YSSout) {
    PHASE_CTX(C0);
    const int w = C.wave;
    const bf16_t* ZX = (const bf16_t*)(P.ws + WS_ZX); const float* DT = (const float*)(P.ws + WS_DT); bf16_t* Y = Yout; float* YSS = YSSout;
    LAS unsigned char* CI = C.lds; LAS unsigned char* BI = C.lds + 32768; LAS unsigned char* XI = C.lds + 65536; LAS unsigned char* SB = C.lds + 98304;
    LAS float* ACU = (LAS float*)(C.lds + XS_OFF); LAS float* DTV = ACU + 128; LAS float* FWV = ACU + 256; LAS float* E2 = ACU + 384 + 128 * w; LAS float* SQT = ACU + 1408; LAS unsigned char* YT = C.lds + 114688; LAS unsigned char* GT = C.lds + GT_OFF;
    const int tt = w < 4 ? (w >> 1) : 3 - ((w - 4) >> 1), pt = w & 1, nt = w >> 1;
    for (int unit = blockIdx.x; unit < NBATCH * SSD_H; unit += C.G) {
        const int bgp = (unit & 7) + 8 * (unit >> 6), b = bgp >> 2, g = bgp & 3, hd = 8 * g + ((unit >> 3) & 7);
        const float a = -__expf(P.a_log[hd]), dbias = P.dt_bias[hd], dskip = P.ssd_d[hd];
        u32x4 pf[12];
        unsigned pfo[12], lwo[12];
        { int tl = TID_FROM_WAVE(w); asm volatile("" : "+v"(tl));
#pragma unroll
          for (int k = 0; k < 12; ++k) { const int j_ = tl + 512 * (k & 3); const int row_ = k < 8 ? (j_ >> 4) : ((tl + 512 * (k & 1)) >> 3), ch_ = k < 8 ? (j_ & 15) : (tl & 7);
              const int col_ = k < 4 ? 2048 + 2560 + g * 128 + ch_ * 8 : (k < 8 ? 2048 + 2048 + g * 128 + ch_ * 8 : (k < 10 ? 2048 + hd * 64 + ch_ * 8 : hd * 64 + ch_ * 8));
              pfo[k] = (unsigned)(((col_ >> 8) * 65536 + row_ * 256 + (col_ & 255)) * 2);
              lwo[k] = (k < 4 ? 0u : (k < 8 ? 32768u : 65536u)) + off_b(row_, k < 8 ? ch_ : (k < 10 ? ch_ : 8 + ch_)); } }
#define SSD2_PREFETCH(c_) do { const GAS char* cb_ = (const GAS char*)ZX + ((size_t)((b * 16 + ((c_) >> 1)) * 20) * 65536 + (size_t)((c_) & 1) * 32768) * 2; \
            _Pragma("unroll") for (int k = 0; k < 12; ++k) pf[k] = *(const GAS u32x4*)(cb_ + pfo[k]); } while (0)
        float dtr0, dtr1;
        { SSD2_PREFETCH(0); const int lane = lane_id(); dtr0 = DT[(size_t)(b * SEQ + lane) * 32 + hd]; dtr1 = DT[(size_t)(b * SEQ + 64 + lane) * 32 + hd]; }
        f32x16 S;
#pragma unroll
        for (int i = 0; i < 16; ++i) S[i] = 0.f;
        for (int c = 0; c < 32; ++c) {
            const int t0 = c * 128;
            int tid = TID_FROM_WAVE(w); asm volatile("" : "+v"(tid));
            const int lane = tid & 63, r = lane & 31, hh = lane >> 5;
            const int pr = (r & 16) + ((r >> 2) & 1) * 8 + ((r >> 3) & 1) * 4 + (r & 3);
            float x0 = dtr0 + dbias, x1 = dtr1 + dbias;
            float dt0 = x0 > 20.f ? x0 : __logf(1.f + __expf(x0)), dt1 = x1 > 20.f ? x1 : __logf(1.f + __expf(x1));
            dt0 = fmaxf(dt0, 1e-30f); dt1 = fmaxf(dt1, 1e-30f);
            float s0 = dt0 * a, s1 = dt1 * a;
            s0 = wave_incl_scan(s0); s1 = wave_incl_scan(s1);
            s1 += lane_val(s0, 63);
            const float a_last = lane_val(s1, 63);
            __builtin_amdgcn_s_barrier(); asm volatile("" ::: "memory");
            ACU[lane] = s0; ACU[64 + lane] = s1; DTV[lane] = dt0; DTV[64 + lane] = dt1; FWV[lane] = __expf(a_last - s0); FWV[64 + lane] = __expf(a_last - s1);
            { const float aref = tt > 0 ? lane_val(tt == 3 ? s1 : s0, tt == 2 ? 63 : 31) : 0.f;
              E2[lane] = __expf(aref - s0); E2[64 + lane] = __expf(aref - s1); }
            LDS_WAIT(); asm volatile("" ::: "memory");
#pragma unroll
            for (int k = 0; k < 8; ++k) *(LAS u32x4*)(C.lds + lwo[k]) = pf[k];
#pragma unroll
            for (int k = 8; k < 10; ++k) { const int row = (tid + 512 * (k - 8)) >> 3; const float d = DTV[row]; const u32x4 v = pf[k]; u32x4 o;
                o.x = pk2(bflo(v.x) * d, bfhi(v.x) * d); o.y = pk2(bflo(v.y) * d, bfhi(v.y) * d); o.z = pk2(bflo(v.z) * d, bfhi(v.z) * d); o.w = pk2(bflo(v.w) * d, bfhi(v.w) * d);
                *(LAS u32x4*)(C.lds + lwo[k]) = o; }
#pragma unroll
            for (int k = 10; k < 12; ++k) *(LAS u32x4*)(C.lds + lwo[k]) = pf[k];
            if (c < 31) { SSD2_PREFETCH(c + 1); dtr0 = DT[(size_t)(b * SEQ + t0 + 128 + lane) * 32 + hd]; dtr1 = DT[(size_t)(b * SEQ + t0 + 192 + lane) * 32 + hd]; }
            LDS_WAIT(); __builtin_amdgcn_s_barrier(); asm volatile("" ::: "memory");
            f32x16 Yv;
#pragma unroll
            for (int i = 0; i < 16; ++i) Yv[i] = 0.f;
            const int crow_c = 32 * tt + r, prow = 32 * pt + r;
            bf16x8 cfr[8];
#pragma unroll
            for (int ks = 0; ks < 8; ++ks) cfr[ks] = *(const LAS bf16x8*)(CI + off_b(crow_c, 2 * ks + hh));
            unsigned bof[8];
#pragma unroll
            for (int ks = 0; ks < 8; ++ks) bof[ks] = off_b(pr, 2 * ks + hh);
            const unsigned trh = lane >> 5, trblk = (lane >> 4) & 1, trq = (lane & 15) >> 2, trp = lane & 3;
            const unsigned xtr0 = off_b(8 * trh + trq, 4 * pt + 2 * trblk + (trp >> 1)) + 8 * (trp & 1), xtr1 = off_b(8 * trh + 4 + trq, 4 * pt + 2 * trblk + (trp >> 1)) + 8 * (trp & 1);
            const unsigned btr0 = off_b(8 * trh + trq, 4 * nt + 2 * trblk + (trp >> 1)) + 8 * (trp & 1), btr1 = off_b(8 * trh + 4 + trq, 4 * nt + 2 * trblk + (trp >> 1)) + 8 * (trp & 1);
#define SSD2_TR(img, a0, a1, kstep) __builtin_shufflevector(__builtin_amdgcn_ds_read_tr16_b64_v4i16((LAS v4i16_t*)((img) + (a0) + 4096 * (kstep))), __builtin_amdgcn_ds_read_tr16_b64_v4i16((LAS v4i16_t*)((img) + (a1) + 4096 * (kstep))), 0, 1, 2, 3, 4, 5, 6, 7)
            if (c > 0) {
#pragma unroll
                for (int ks = 0; ks < 8; ++ks) { const bf16x8 bfv = *(const LAS bf16x8*)(SB + off_b(prow, 2 * ks + hh));
                    Yv = __builtin_amdgcn_mfma_f32_32x32x16_bf16(cfr[ks], bfv, Yv, 0, 0, 0); }
#pragma unroll
                for (int q4 = 0; q4 < 4; ++q4) { const f32x4 ac = *(const LAS f32x4*)(ACU + 32 * tt + 8 * q4 + 4 * hh);
#pragma unroll
                    for (int j = 0; j < 4; ++j) Yv[4 * q4 + j] *= __expf(ac[j]); }
            }
            const float act = ACU[crow_c], ddiag = dskip * __builtin_amdgcn_rcpf(DTV[crow_c]);
            const float f1 = tt > 0 ? __expf(act - ACU[32 * tt - 1]) : 1.f;
            for (int st = pt; st <= tt; st += 2) {
                f32x16 X;
#pragma unroll
                for (int i = 0; i < 16; ++i) X[i] = 0.f;
                const LAS unsigned char* bt = BI + 8192 * st;
#pragma unroll
                for (int ks = 0; ks < 8; ++ks) { const bf16x8 af = *(const LAS bf16x8*)(bt + bof[ks]);
                    X = __builtin_amdgcn_mfma_f32_32x32x16_bf16(af, cfr[ks], X, 0, 0, 0); }
                if (st < tt) {
                    asm volatile("; past tile" ::: "memory");
#pragma unroll
                    for (int q4 = 0; q4 < 4; ++q4) { const int sb = 32 * st + 16 * (q4 >> 1) + 8 * hh + 4 * (q4 & 1); const f32x4 e2 = *(const LAS f32x4*)(E2 + sb);
#pragma unroll
                        for (int j = 0; j < 4; ++j) X[4 * q4 + j] *= f1 * e2[j]; }
                } else {
                    asm volatile("; diagonal tile" ::: "memory");
#pragma unroll
                    for (int q4 = 0; q4 < 4; ++q4) { const int sb = 32 * st + 16 * (q4 >> 1) + 8 * hh + 4 * (q4 & 1); const f32x4 as = *(const LAS f32x4*)(ACU + sb);
#pragma unroll
                        for (int j = 0; j < 4; ++j) { const int s = sb + j; float v = X[4 * q4 + j] * __expf(act - as[j]); v = (s <= crow_c) ? v : 0.f; v = (s == crow_c) ? v + ddiag : v; X[4 * q4 + j] = v; } }
                }
                u32x4 pa0, pa1;
                pa0.x = cvtpk(X[0], X[1]); pa0.y = cvtpk(X[2], X[3]); pa0.z = cvtpk(X[4], X[5]); pa0.w = cvtpk(X[6], X[7]);
                pa1.x = cvtpk(X[8], X[9]); pa1.y = cvtpk(X[10], X[11]); pa1.z = cvtpk(X[12], X[13]); pa1.w = cvtpk(X[14], X[15]);
                LAS unsigned char* gp = GT + (tt * (tt + 1) / 2 + st) * 2048 + lane * 16;
                *(LAS u32x4*)gp = pa0; *(LAS u32x4*)(gp + 1024) = pa1;
            }
            LDS_WAIT(); __builtin_amdgcn_s_barrier(); asm volatile("" ::: "memory");
            for (int st = 0; st <= tt; ++st) {
                const LAS unsigned char* gp = GT + (tt * (tt + 1) / 2 + st) * 2048 + lane * 16;
                const bf16x8 pa0 = *(const LAS bf16x8*)gp, pa1 = *(const LAS bf16x8*)(gp + 1024);
                const LAS unsigned char* xt = XI + 8192 * st;
                const bf16x8 xv0 = SSD2_TR(xt, xtr0, xtr1, 0), xv1 = SSD2_TR(xt, xtr0, xtr1, 1);
                Yv = __builtin_amdgcn_mfma_f32_32x32x16_bf16(pa0, xv0, Yv, 0, 0, 0);
                Yv = __builtin_amdgcn_mfma_f32_32x32x16_bf16(pa1, xv1, Yv, 0, 0, 0);
            }
            {
                float sq[16];
#pragma unroll
                for (int i = 0; i < 16; ++i) { const int t = 32 * tt + (i & 3) + 8 * (i >> 2) + 4 * hh;
                    const float z = bf2f(*(const LAS unsigned short*)(XI + off_b(t, 8 + 4 * pt + (r >> 3)) + 2 * (r & 7))); const float y = Yv[i] * silu_f(z);
                    *(LAS unsigned short*)(YT + t * 128 + (32 * pt + r) * 2) = (unsigned short)f2bf(y); sq[i] = y * y; }
#pragma unroll
                for (int i = 0; i < 16; ++i) { sq[i] = dpp_row_sum(sq[i]); sq[i] += shx(sq[i], 16); }
                if (r == 0) {
#pragma unroll
                    for (int i = 0; i < 16; ++i) { const int t = 32 * tt + (i & 3) + 8 * (i >> 2) + 4 * hh; SQT[t * 2 + pt] = sq[i]; }
                }
            }
            LDS_WAIT();
            __builtin_amdgcn_s_barrier(); asm volatile("" ::: "memory");
            {
#pragma unroll
                for (int k = 0; k < 2; ++k) { const int row = (tid >> 3) + 64 * k, ch = tid & 7;
                    *(GAS u32x4*)(Y + (size_t)(b * SEQ + t0 + row) * SSD_DI + hd * 64 + ch * 8) = *(const LAS u32x4*)(YT + row * 128 + ch * 16); }
                if (tid < 128) *(GAS f32x2*)(YSS + (size_t)(b * SEQ + t0 + tid) * 64 + hd * 2) = *(const LAS f32x2*)(SQT + tid * 2);
            }
            {
                const float dec = __expf(a_last);
#pragma unroll
                for (int i = 0; i < 16; ++i) S[i] *= dec;
#pragma unroll
                for (int kb = 0; kb < 8; kb += 4) {
                    bf16x8 af[4], xr[4];
#pragma unroll
                    for (int u = 0; u < 4; ++u) { af[u] = SSD2_TR(BI, btr0, btr1, kb + u); xr[u] = SSD2_TR(XI, xtr0, xtr1, kb + u); }
#pragma unroll
                    for (int u = 0; u < 4; ++u) { const int ks = kb + u;
                        const f32x4 f0 = *(const LAS f32x4*)(FWV + 16 * ks + 8 * hh), f1v = *(const LAS f32x4*)(FWV + 16 * ks + 8 * hh + 4);
                        u32x4 xw; const u32x4 xu = __builtin_bit_cast(u32x4, xr[u]);
                        xw.x = pk2(bflo(xu.x) * f0[0], bfhi(xu.x) * f0[1]); xw.y = pk2(bflo(xu.y) * f0[2], bfhi(xu.y) * f0[3]); xw.z = pk2(bflo(xu.z) * f1v[0], bfhi(xu.z) * f1v[1]); xw.w = pk2(bflo(xu.w) * f1v[2], bfhi(xu.w) * f1v[3]);
                        S = __builtin_amdgcn_mfma_f32_32x32x16_bf16(af[u], __builtin_bit_cast(bf16x8, xw), S, 0, 0, 0); }
                }
#pragma unroll
                for (int q4 = 0; q4 < 4; ++q4) { u32x2 wv; wv.x = cvtpk(S[4 * q4], S[4 * q4 + 1]); wv.y = cvtpk(S[4 * q4 + 2], S[4 * q4 + 3]);
                    *(LAS u32x2*)(SB + off_b(prow, 4 * nt + q4) + 8 * hh) = wv; }
            }
        }
        __builtin_amdgcn_s_barrier();
    }
    VM_WAIT(); __builtin_amdgcn_s_barrier();
#undef SSD2_PREFETCH
#undef SSD2_TR
}
#define PHASE_PARAMS() const Params& P = Pk; unsigned char* ws = P.ws; (void)ws
__global__ void __launch_bounds__(NTHR, 2) fwd_kernel(Params Pk) {
    extern __shared__ __attribute__((aligned(16))) unsigned char lds_raw[];
    Ctx C;
    C.lds = (LAS unsigned char*)lds_raw;
    C.wave = __builtin_amdgcn_readfirstlane((int)threadIdx.x >> 6); C.tid = TID_FROM_WAVE(C.wave); C.lane = C.tid & 63;
    C.G = gridDim.x; C.gw = blockIdx.x * NWAVES + C.wave; C.NGW = C.G * NWAVES;
    volatile LAS unsigned* MISC = (volatile LAS unsigned*)(C.lds + MISC_OFF);
    if (C.tid < 16) MISC[C.tid] = 0u;
    __syncthreads();
    XcdBarrier bar; { PHASE_PARAMS(); bar = xcd_barrier_post((unsigned*)(ws + WS_CTL) + CW_BAR, MISC + 8, TID_FROM_WAVE(C.wave) == 0); }
#define GRID_BAR() xcd_barrier(bar, TID_FROM_WAVE(C.wave) == 0)
#define LOCAL_BAR() __syncthreads()

#define WSM ((bf16_t*)(ws + WS_WSMALL))
#define SS ((float*)(ws + WS_SS))
    LAS unsigned char* ring = C.lds;
    LAS float* XS = (LAS float*)(C.lds + XS_OFF);
    const int G = C.G, cb = blockIdx.x;

    { PHASE_PARAMS(); p0_prologue(P, C); }
    GRID_BAR();
    {   PHASE_PARAMS();
        SchedHyIn S{(const char*)(ws + WS_HNA), (const char*)(WSM + WO_HYIN), (const char*)(WSM + WO_HYV), G, cb};
        bf16_t* Q = (bf16_t*)(ws + WS_QKU);
        EpiHyIn E{Q, Q + (size_t)NTOK * 512, Q + (size_t)2 * NTOK * 512, (bf16_t*)(ws + WS_VT), P.hy_qn, P.hy_kn, (const float*)(ws + WS_ROPE), (float*)(ws + WS_KMP)};
        pg8::gemm_phase<false, false>(ring, C.wave, 2048, 2048, 2048, S, E);
    }
    GRID_BAR();
    { PHASE_PARAMS(); moba_mfma(P, C); }
    { PHASE_PARAMS(); pool_mfma(P, C); }
    GRID_BAR();
    {   PHASE_PARAMS();
        SchedPlain S{(const char*)(ws + WS_AP), (const char*)(WSM + WO_HYOUT), 128, 4, 2048, 2048, G, cb};
        EpiRes<XA_FP8 != 0, true> E{P.x, P.out, (void*)(ws + WS_HNA), P.xa_norm, SS, 1.f};
        pg8::gemm_phase<false, false>(ring, C.wave, 2048, 2048, 2048, S, E);
    }
    GRID_BAR();
    {   PHASE_PARAMS();
        SchedXaProj S{(const char*)(ws + WS_HNA), (const char*)(ws + WS_W8 + W8_XAQ), (const char*)(ws + WS_MEMN), (const char*)(ws + WS_W8 + W8_XAK), (const char*)(ws + WS_W8 + W8_XAV), 0, 0, 2, G, cb};
        EpiXaProj E{(bf16_t*)(ws + WS_QXA), (bf16_t*)(ws + WS_KXA), (bf16_t*)(ws + WS_VTXA), P.xa_qn, P.xa_kn, SS, XS};
        pg8::gemm_phase<false, XA_FP8 != 0>(ring, C.wave, 1024 * XAB, 1024 * XAB, 1024 * XAB, S, E);
    }
    GRID_BAR();
    {   PHASE_PARAMS();
        SchedXaAttn S{(const char*)(ws + WS_QXA), (const char*)(ws + WS_KXA), (size_t)256 * 2048, (size_t)512, G, cb};
        EpiXaS E{(bf16_t*)(ws + WS_PXA), (float*)(ws + WS_PSUM)};
        pg8::gemm_phase<true, false>(ring, C.wave, 2048, 2048, 512, S, E);
    }
    LOCAL_BAR();
    {   PHASE_PARAMS();
        SchedXaAttn S{(const char*)(ws + WS_PXA), (const char*)(ws + WS_VTXA), (size_t)512, (size_t)256 * 4096, G, cb};
        EpiXaO E{(unsigned char*)(ws + WS_OXA), (const float*)(ws + WS_PSUM)};
        pg8::gemm_phase<true, false>(ring, C.wave, 2048, 4096, 512, S, E);
    }
    GRID_BAR();
    {   PHASE_PARAMS();
        SchedPlain S{(const char*)(ws + WS_OXA), (const char*)(ws + WS_W8 + W8_XAO), 128, 4, 1024 * XAB, 1024 * XAB, G, cb};
        EpiRes<FFN_FP8 != 0> E{P.out, P.out, (void*)(ws + WS_HNA), P.ffn_norm, SS, 1.f / XAWS};
        pg8::gemm_phase<false, XA_FP8 != 0>(ring, C.wave, 1024 * XAB, 1024 * XAB, 1024 * XAB, S, E);
    }
    GRID_BAR();
    {   PHASE_PARAMS();
#if FFN_FP8
        SchedPlain S{(const char*)(ws + WS_HNA), (const char*)(ws + WS_W8 + W8_FGU), 128, 22, 1024, 1024, G, cb};
        EpiGU8 E{(unsigned char*)(ws + WS_HID), DFF, SS, nullptr};
        pg8::gemm_phase<false, true>(ring, C.wave, 1024, 1024, 1024, S, E);
#else
        SchedPlain S{(const char*)(ws + WS_HNA), (const char*)(ws + WS_W8 + W8_FGU), 128, 22, 2048, 2048, G, cb};
        EpiGU E{(bf16_t*)(ws + WS_HID), DFF, SS, nullptr, 0};
        pg8::gemm_phase<false, false>(ring, C.wave, 2048, 2048, 2048, S, E);
#endif
    }
    GRID_BAR();
    {   PHASE_PARAMS();
#if FFN_FP8
        SchedPlain S{(const char*)(ws + WS_HID), (const char*)(ws + WS_W8 + W8_FDN), 128, 4, DFF, DFF, G, cb};
        EpiRes<false> E{P.out, P.out, (void*)(ws + WS_HNA), P.mix_norm + DM, SS, 1.f / (MOE_WSCALE * MOE_HSCALE)};
        pg8::gemm_phase<false, true>(ring, C.wave, DFF, DFF, DFF, S, E);
#else
        SchedPlain S{(const char*)(ws + WS_HID), (const char*)(ws + WS_W8 + W8_FDN), 128, 4, DFF * 2, DFF * 2, G, cb};
        EpiRes<false> E{P.out, P.out, (void*)(ws + WS_HNA), P.mix_norm + DM, SS, 1.f};
        pg8::gemm_phase<false, false>(ring, C.wave, DFF * 2, DFF * 2, DFF * 2, S, E);
#endif
    }
    GRID_BAR();
    {   PHASE_PARAMS();
        SchedPlain S{(const char*)(ws + WS_HNA), (const char*)(WSM + WO_SIN), 128, 20, 2048, 2048, G, cb};
        EpiSsdIn E{(bf16_t*)(ws + WS_ZX), (float*)(ws + WS_DT), SS, (bf16_t*)(ws + WS_HALO)};
        pg8::gemm_phase<false, false>(ring, C.wave, 2048, 2048, 2048, S, E);
    }
    GRID_BAR();
    { PHASE_PARAMS(); ssd_conv_prepass(P, C); }
    GRID_BAR();
    { PHASE_PARAMS(); ssd_chunked2(P, C, (bf16_t*)(ws + WS_Y), (float*)(ws + WS_YSS)); }
    GRID_BAR();
    {   PHASE_PARAMS();
        SchedPlain S{(const char*)(ws + WS_Y), (const char*)(WSM + WO_SOUT), 128, 4, 4096, 4096, G, cb};
        EpiResSeg E{P.out, P.out, (void*)(ws + WS_HNA2), P.xa_norm + DM, SS, (const float*)(ws + WS_YSS), XS};
        pg8::gemm_phase<false, false, true>(ring, C.wave, 4096, 4096, 4096, S, E);
    }
    GRID_BAR();
    {   PHASE_PARAMS();
        SchedXaProj S{(const char*)(ws + WS_HNA2), (const char*)(ws + WS_W8 + W8_XAQ + (size_t)1024 * 1024 * XAB), (const char*)(ws + WS_MEMN), (const char*)(ws + WS_W8 + W8_XAK), (const char*)(ws + WS_W8 + W8_XAV), 1, 0, 0, G, cb};
        EpiXaProj E{(bf16_t*)(ws + WS_QXA1), (bf16_t*)(ws + WS_KXA), (bf16_t*)(ws + WS_VTXA), P.xa_qn + 256, P.xa_kn, SS, XS};
        pg8::gemm_phase<false, XA_FP8 != 0>(ring, C.wave, 1024 * XAB, 1024 * XAB, 1024 * XAB, S, E);
    }
    LOCAL_BAR();
    {   PHASE_PARAMS();
        SchedXaAttn S{(const char*)(ws + WS_QXA1), (const char*)(ws + WS_KXA + (size_t)2048 * 2048), (size_t)256 * 2048, (size_t)512, G, cb};
        EpiXaS E{(bf16_t*)(ws + WS_PXA1), (float*)(ws + WS_PSUM)};
        pg8::gemm_phase<true, false>(ring, C.wave, 2048, 2048, 512, S, E);
    }
    LOCAL_BAR();
    {   PHASE_PARAMS();
        SchedXaAttn S{(const char*)(ws + WS_PXA1), (const char*)(ws + WS_VTXA + (size_t)1024 * 4096), (size_t)512, (size_t)256 * 4096, G, cb};
        EpiXaO E{(unsigned char*)(ws + WS_OXA1), (const float*)(ws + WS_PSUM)};
        pg8::gemm_phase<true, false>(ring, C.wave, 2048, 4096, 512, S, E);
    }
    GRID_BAR();
    {   PHASE_PARAMS();
        SchedPlain S{(const char*)(ws + WS_OXA1), (const char*)(ws + WS_W8 + W8_XAO + (size_t)1024 * 1024 * XAB), 128, 4, 1024 * XAB, 1024 * XAB, G, cb};
        EpiResRt E{P.out, P.out, (void*)(ws + WS_HNA3), P.ffn_norm + DM, SS, 1.f / XAWS, P.router, (float*)(ws + WS_LP)};
        pg8::gemm_phase<false, XA_FP8 != 0>(ring, C.wave, 1024 * XAB, 1024 * XAB, 1024 * XAB, S, E);
    }
    GRID_BAR();
    { PHASE_PARAMS(); moe_router(P, C); }
    __syncthreads();
    { PHASE_PARAMS(); moe_weight_cvt<false>(P, C); }
    GRID_BAR();
    { PHASE_PARAMS(); moe_scatter(P, C); }
    GRID_BAR();
    {
        PHASE_PARAMS();
        const int* blke = (const int*)(ws + WS_ROUTE + RT_BLKE); const int nb = __builtin_amdgcn_readfirstlane(blke[264]);
        { const int t_ = TID_FROM_WAVE(C.wave); if (t_ < 264) ((LAS int*)XS)[t_] = blke[t_]; __syncthreads(); }
        const unsigned char* WM = (const unsigned char*)(ws + WS_WMOE8);
        {
            SchedMoe<(size_t)256 * 1024, (size_t)7168 * 1024, (size_t)256 * 1024, 28> S{(const char*)(ws + WS_XBUF8), (const char*)(WM + WM8_GU), (const LAS int*)XS, nb, G, cb};
            EpiGU8 E{(unsigned char*)(ws + WS_HMOE8), DFE, nullptr, (const float*)(ws + WS_ROUTE + RT_RSD)};
            pg8::gemm_phase<false, true>(ring, C.wave, 1024, 1024, 1024, S, E);
        }
        { PHASE_PARAMS(); __syncthreads(); moe_weight_cvt<true>(P, C); }
        GRID_BAR();
        {
            SchedMoeDn<(size_t)256 * DFE, (size_t)1024 * DFE, (size_t)256 * DFE> S{(const char*)(ws + WS_HMOE8), (const char*)(WM + WM8_DN), (const LAS int*)XS, nb, G, cb};
            EpiMoeDn E{(bf16_t*)(ws + WS_YBUF), (float*)(ws + WS_XBUF8), 1.f / (MOE_WSCALE * MOE_HSCALE)};
            pg8::gemm_phase<false, true>(ring, C.wave, DFE, DFE, DFE, S, E);
        }
        GRID_BAR();
    }
    { PHASE_PARAMS(); moe_combine(P, C); }
}

extern "C" void kernel_launch(void* const* d_in, const int* in_sizes, int n_in, void* d_out, int out_size, void* d_ws, size_t ws_size, hipStream_t stream) {
    static int grid = 0;
    if (grid == 0) {
        if (n_in != 33 || out_size != NTOK * DM || ws_size < WS_END) { fprintf(stderr, "kernel_launch: unexpected shapes (n_in %d, out %d, ws %zu, need %zu)\n", n_in, out_size, ws_size, (size_t)WS_END); grid = -1; return; }
        int dev = 0, cus = 0, per_cu = 0;
        if (hipGetDevice(&dev) != hipSuccess || hipDeviceGetAttribute(&cus, hipDeviceAttributeMultiprocessorCount, dev) != hipSuccess) { grid = -1; return; }
        if (hipFuncSetAttribute((const void*)fwd_kernel, hipFuncAttributeMaxDynamicSharedMemorySize, LDS_BYTES) != hipSuccess) { fprintf(stderr, "kernel_launch: hipFuncSetAttribute failed\n"); grid = -1; return; }
        if (hipOccupancyMaxActiveBlocksPerMultiprocessor(&per_cu, (const void*)fwd_kernel, NTHR, LDS_BYTES) != hipSuccess || per_cu < 1) { fprintf(stderr, "kernel_launch: occupancy query says %d\n", per_cu); }
        (void)hipGetLastError();
        grid = cus;
    }
    if (grid < 0) return;
    (void)hipMemsetAsync((char*)d_ws + WS_CTL, 0, CTL_ZERO_BYTES, stream);
    Params p{};
    p.x = (const float*)d_in[0]; p.mem = (const float*)d_in[1]; p.pos = (const int*)d_in[2];
    p.mix_norm = (const float*)d_in[3]; p.xa_norm = (const float*)d_in[4]; p.mem_norm = (const float*)d_in[5]; p.ffn_norm = (const float*)d_in[6];
    p.xa_wq = (const float*)d_in[7]; p.xa_wkv = (const float*)d_in[8]; p.xa_qn = (const float*)d_in[9]; p.xa_kn = (const float*)d_in[10]; p.xa_wo = (const float*)d_in[11];
    p.hy_w_in = (const float*)d_in[12]; p.hy_qn = (const float*)d_in[13]; p.hy_kn = (const float*)d_in[14]; p.pool_w = (const float*)d_in[15]; p.pool_scale = (const float*)d_in[16]; p.hy_w_out = (const float*)d_in[17];
    p.ffn_wg = (const float*)d_in[18]; p.ffn_wu = (const float*)d_in[19]; p.ffn_wd = (const float*)d_in[20];
    p.ssd_w_in = (const float*)d_in[21]; p.conv_w = (const float*)d_in[22]; p.conv_b = (const float*)d_in[23]; p.dt_bias = (const float*)d_in[24]; p.a_log = (const float*)d_in[25]; p.ssd_d = (const float*)d_in[26];
    p.ssd_norm = (const float*)d_in[27]; p.ssd_w_out = (const float*)d_in[28];
    p.router = (const float*)d_in[29]; p.moe_wg = (const float*)d_in[30]; p.moe_wu = (const float*)d_in[31]; p.moe_wd = (const float*)d_in[32];
    p.out = (float*)d_out; p.ws = (unsigned char*)d_ws; p.ph_lo = 0; p.ph_hi = 100;
    hipLaunchKernelGGL(fwd_kernel, dim3(grid), dim3(NTHR), LDS_BYTES, stream, p);
    const hipError_t le = hipPeekAtLastError();
    if (le != hipSuccess) fprintf(stderr, "kernel_launch: launch failed: %s\n", hipGetErrorName(le));
}
```

```cpp
#include <hip/hip_runtime.h>
#include <cstdio>
#include <cstdint>

#define LAS __attribute__((address_space(3)))
#define GAS __attribute__((address_space(1)))
typedef unsigned short bf16_t;
typedef short bf16x8 __attribute__((ext_vector_type(8)));
typedef short s16x4 __attribute__((ext_vector_type(4)));
typedef float f32x2 __attribute__((ext_vector_type(2)));
typedef float f32x4 __attribute__((ext_vector_type(4)));
typedef float f32x16 __attribute__((ext_vector_type(16)));
typedef unsigned u32x2 __attribute__((ext_vector_type(2)));
typedef unsigned u32x4 __attribute__((ext_vector_type(4)));
#define DI __device__ __forceinline__

constexpr int NTOK = 32768, DM = 1024, SEQ = 4096, NBATCH = 8, NMEM = 256;
constexpr int HY_H = 8, HY_HD = 64, ATTW = 512, POOLW = 512;
constexpr int DFF = 2816, SSD_DI = 2048, SSD_XBC = 3072, SSD_H = 32, SSD_N = 128, SSD_G = 4, ZXW = 5120, SSD_INP = 5376;
constexpr int NEXP = 8, DFE = 3584, MOE_ROWS_MAX = 264 * 256;
constexpr float EPS = 1e-6f;
constexpr int NWAVES = 8, NTHR = 512;

constexpr size_t MiB = 1u << 20;
constexpr size_t WS_CTL = 0, CTL_ZERO_BYTES = 1 * MiB;
constexpr size_t WS_ROPE = 1 * MiB;
constexpr size_t WS_SS = 2 * MiB;
constexpr size_t WS_KMP = 4 * MiB;
constexpr size_t WS_PSUM = 2 * MiB;
constexpr size_t WS_WPOOL = 4 * MiB + 512 * 1024;
constexpr size_t WS_ROUTE = 5 * MiB;
constexpr size_t WS_YSS = 7 * MiB;
constexpr size_t WS_DT = 15 * MiB;
constexpr size_t WS_WSMALL = 20 * MiB;
constexpr size_t WS_KXA = 76 * MiB;
constexpr size_t WS_VTXA = 84 * MiB;
constexpr size_t WS_MEMN = 92 * MiB;
constexpr size_t WS_HNA = 100 * MiB;
constexpr size_t WS_QKU = 164 * MiB;
constexpr size_t WS_VT = 260 * MiB;
constexpr size_t WS_AP = 292 * MiB;
constexpr size_t WS_QXA = 164 * MiB, WS_PXA = 228 * MiB, WS_OXA = 292 * MiB;
constexpr size_t WS_HID = 164 * MiB;
constexpr size_t WS_HALO = 164 * MiB;
constexpr size_t WS_ZX = 256 * MiB;
constexpr size_t WS_Y = 100 * MiB;
constexpr size_t WS_HNA2 = 256 * MiB;
constexpr size_t WS_QXA1 = 100 * MiB, WS_PXA1 = 164 * MiB, WS_OXA1 = 320 * MiB;
constexpr size_t WS_HNA3 = 384 * MiB;
constexpr size_t WS_LP = 420 * MiB;
constexpr size_t WS_WMOE = 20 * MiB;
constexpr size_t WS_XBUF = 188 * MiB;
constexpr size_t WS_HMOE = 320 * MiB;
constexpr size_t WS_WMOE8 = 20 * MiB;
constexpr size_t WS_XBUF8 = 104 * MiB;
constexpr size_t WS_YBUF = 170 * MiB;
constexpr size_t WS_HMOE8 = 302 * MiB;
constexpr size_t WM8_GU = 0, WM8_DN = (size_t)8 * 7168 * 1024;
constexpr float MOE_WSCALE = 64.f, MOE_HSCALE = 8.f;
constexpr size_t WS_END = 576 * MiB;
constexpr size_t WO_HYIN = 0;
constexpr size_t WO_HYV = WO_HYIN + (size_t)1536 * 1024;
constexpr size_t WO_HYOUT = WO_HYV + (size_t)512 * 1024;
constexpr size_t WO_XAQ = WO_HYOUT + (size_t)1024 * 1024;
constexpr size_t WO_XAK = WO_XAQ + (size_t)2 * 1024 * 1024;
constexpr size_t WO_XAV = WO_XAK + (size_t)2 * 1024 * 1024;
constexpr size_t WO_XAO = WO_XAV + (size_t)2 * 1024 * 1024;
constexpr size_t WO_FGU = WO_XAO + (size_t)2 * 1024 * 1024;
constexpr size_t WO_FDN = WO_FGU + (size_t)5632 * 1024;
constexpr size_t WO_SIN = WO_FDN + (size_t)1024 * 2816;
constexpr size_t WO_SOUT = WO_SIN + (size_t)5376 * 1024;
constexpr size_t WO_END = WO_SOUT + (size_t)1024 * 2048;
static_assert(WO_END * 2 <= 56 * MiB, "small weights fit");
constexpr size_t WS_W8 = WS_WSMALL + WO_XAQ * 2;
#ifndef FFN_FP8
#define FFN_FP8 0
#endif
#ifndef XA_FP8
#define XA_FP8 1
#endif
constexpr int XAB = XA_FP8 ? 1 : 2;
constexpr float XAWS = XA_FP8 ? 64.f : 1.f;
constexpr size_t W8_XAQ = 0, W8_XAK = 4 * MiB, W8_XAV = 8 * MiB, W8_XAO = 12 * MiB, W8_FGU = 16 * MiB, W8_FDN = 27 * MiB;
static_assert(W8_FDN + (size_t)1024 * 2816 * 2 <= (WO_SIN - WO_XAQ) * 2, "fp8 weights fit below the ssd in-projection copy");
constexpr size_t WM_GU = 0, WM_DN = (size_t)8 * 7168 * 1024;
constexpr size_t RT_E = 0, RT_G = 256 * 1024, RT_RANK = 512 * 1024, RT_DEST = 768 * 1024, RT_RS = 1024 * 1024, RT_CNT = 1152 * 1024, RT_BLKE = 1168 * 1024, RT_RSD = 1280 * 1024;
constexpr int CW_BAR = 4096;

constexpr int RING_BYTES = 131072;
constexpr int XS_OFF = RING_BYTES;
constexpr int MISC_OFF = XS_OFF + 8192;
constexpr int GT_OFF = MISC_OFF + 64;
constexpr int LDS_BYTES = 163840;

struct Params {
    const float* x; const float* mem; const int* pos;
    const float* mix_norm; const float* xa_norm; const float* mem_norm; const float* ffn_norm;
    const float* xa_wq; const float* xa_wkv; const float* xa_qn; const float* xa_kn; const float* xa_wo;
    const float* hy_w_in; const float* hy_qn; const float* hy_kn; const float* pool_w; const float* pool_scale; const float* hy_w_out;
    const float* ffn_wg; const float* ffn_wu; const float* ffn_wd;
    const float* ssd_w_in; const float* conv_w; const float* conv_b; const float* dt_bias; const float* a_log; const float* ssd_d; const float* ssd_norm; const float* ssd_w_out;
    const float* router; const float* moe_wg; const float* moe_wu; const float* moe_wd;
    float* out; unsigned char* ws;
    int ph_lo, ph_hi;
};

DI unsigned f2bf(float f) { unsigned u = __builtin_bit_cast(unsigned, f); return (u + 0x7fffu + ((u >> 16) & 1u)) >> 16; }
DI unsigned pk2(float lo, float hi) { unsigned r; asm volatile("v_cvt_pk_bf16_f32 %0, %1, %2" : "=v"(r) : "v"(lo), "v"(hi)); return r; }
DI float bf2f(unsigned short b) { return __builtin_bit_cast(float, ((unsigned)b) << 16); }
DI float bflo(unsigned w) { return __builtin_bit_cast(float, w << 16); }
DI float bfhi(unsigned w) { return __builtin_bit_cast(float, w & 0xffff0000u); }
DI unsigned pk4_fp8(float a, float b, float c, float d) { int w = 0; w = __builtin_amdgcn_cvt_pk_fp8_f32(a, b, w, false); w = __builtin_amdgcn_cvt_pk_fp8_f32(c, d, w, true); return (unsigned)w; }
DI size_t zx_off(int row, int col) { return ((size_t)(row >> 8) * 20 + (col >> 8)) * 65536 + (size_t)(row & 255) * 256 + (col & 255); }
DI float dot4f(const f32x4& a) { return (a[0] * a[0] + a[1] * a[1]) + (a[2] * a[2] + a[3] * a[3]); }
DI float silu_f(float x) { return x * __builtin_amdgcn_rcpf(1.f + __expf(-x)); }
DI int lane_id() { int r; asm volatile("v_mbcnt_lo_u32_b32 %0, -1, 0\n\tv_mbcnt_hi_u32_b32 %0, -1, %0" : "=v"(r)); return r; }
template <int O> DI float shx_c(float v) {
    if constexpr (O < 32) return __builtin_bit_cast(float, __builtin_amdgcn_ds_swizzle(__builtin_bit_cast(int, v), (O << 10) | 0x1f));
    else return __builtin_bit_cast(float, __builtin_amdgcn_ds_bpermute((lane_id() ^ O) << 2, __builtin_bit_cast(int, v)));
}
DI float shx(float v, int o) { switch (o) { case 1: return shx_c<1>(v); case 2: return shx_c<2>(v); case 4: return shx_c<4>(v); case 8: return shx_c<8>(v); case 16: return shx_c<16>(v); default: return shx_c<32>(v); } }
DI float dpp_row_sum(float x) {
    x += __builtin_bit_cast(float, __builtin_amdgcn_update_dpp(0, __builtin_bit_cast(int, x), 0xB1, 0xf, 0xf, false));
    x += __builtin_bit_cast(float, __builtin_amdgcn_update_dpp(0, __builtin_bit_cast(int, x), 0x4E, 0xf, 0xf, false));
    x += __builtin_bit_cast(float, __builtin_amdgcn_update_dpp(0, __builtin_bit_cast(int, x), 0x141, 0xf, 0xf, false));
    x += __builtin_bit_cast(float, __builtin_amdgcn_update_dpp(0, __builtin_bit_cast(int, x), 0x140, 0xf, 0xf, false));
    return x;
}
DI float shl_from(float v, int src_lane) { return __builtin_bit_cast(float, __builtin_amdgcn_ds_bpermute(src_lane << 2, __builtin_bit_cast(int, v))); }
DI float wave_incl_scan(float x) {
#define DPPF_(x_, ctrl_, rm_) __builtin_bit_cast(float, __builtin_amdgcn_update_dpp(0, __builtin_bit_cast(int, x_), ctrl_, rm_, 0xf, false))
    x += DPPF_(x, 0x111, 0xf); x += DPPF_(x, 0x112, 0xf); x += DPPF_(x, 0x114, 0xf); x += DPPF_(x, 0x118, 0xf);
    x += DPPF_(x, 0x142, 0xa);
    x += DPPF_(x, 0x143, 0xc);
#undef DPPF_
    return x;
}
DI float lane_val(float v, int l) { return __builtin_bit_cast(float, __builtin_amdgcn_readlane(__builtin_bit_cast(int, v), l)); }
DI float wave_sum(float v) {
#pragma unroll
    for (int o = 1; o < 64; o <<= 1) v += shx(v, o);
    return v;
}
#define TID_FROM_WAVE(wave_) ((wave_) * 64 + lane_id())
#define LDS_WAIT() asm volatile("s_waitcnt lgkmcnt(0)" ::: "memory")
#define VM_WAIT() asm volatile("s_waitcnt vmcnt(0)" ::: "memory")
#ifndef PG8_SP2
#define PG8_SP2 1
#endif
namespace pg8 {
constexpr int BM = 256, BK = 64, HALF = 128, HTB = HALF * BK * 2, STAGE_BYTES = 8 * HTB, NXCD = 8, WGM = 8;
__host__ __device__ __forceinline__ int lds_byte(int r, int c) { const int st = (r >> 4) * 2 + (c >> 5), rr = r & 15, cc = c & 31, ob = rr * 64 + cc * 2; return st * 1024 + (ob ^ (((ob >> 9) & 1) << 5)); }
__host__ __device__ __forceinline__ void stage_rc(int b, int& R, int& C) { const int st = b / 1024, sb = b % 1024, swz = sb ^ (((sb >> 9) & 1) << 5); R = (st >> 1) * 16 + swz / 64; C = (st & 1) * 32 + (swz % 64) / 2; }
__host__ __device__ __forceinline__ int perm32(int rho) { const int n = rho >> 4, i = rho & 15; return 8 * (i >> 2) + 4 * n + (i & 3); }

struct Unit { const char* A; const char* B; int pm, pn, kind, aux; };

DI void tile_of(int L, int nM, int nN, int& pm, int& pn) {
    const int nwg = nM * nN; int wgid = L;
    { const int q = nwg / NXCD, r = nwg % NXCD, xcd = wgid % NXCD, off = wgid / NXCD; wgid = (xcd < r ? xcd * (q + 1) : r * (q + 1) + (xcd - r) * q) + off; }
    const int nig = WGM * nN, gid = wgid / nig, fm = gid * WGM, gsz = (nM - fm) < WGM ? (nM - fm) : WGM;
    pm = fm + ((wgid % nig) % gsz); pn = (wgid % nig) / gsz;
}

typedef int v4i_t __attribute__((ext_vector_type(4)));
typedef int v8i_t __attribute__((ext_vector_type(8)));
DI v8i_t cat8(const bf16x8& a, const bf16x8& b) { return __builtin_shufflevector(__builtin_bit_cast(v4i_t, a), __builtin_bit_cast(v4i_t, b), 0, 1, 2, 3, 4, 5, 6, 7); }
template <bool PERMB, bool FP8, bool SEG = false, class Epi, class Sched>
DI void gemm_phase(LAS unsigned char* lds, const int wave_id, const int lda_b, const int ldb_b, const int kbytes, const Sched& S, const Epi& E) {
    int tid = TID_FROM_WAVE(wave_id); asm volatile("" : "+v"(tid));
    const int wid = wave_id, lane = tid & 63, wr = wid >> 2, wc = wid & 3, fr = lane & 15, fq = lane >> 4;
    const int nt = kbytes >> 7;
    unsigned voffA, voffB;
    { int R, C; stage_rc(tid * 16, R, C); const int Rb = PERMB ? ((R & ~31) + perm32(R & 31)) : R; voffA = (unsigned)(R * lda_b + C * 2); voffB = (unsigned)(Rb * ldb_b + C * 2); }
    const size_t qvoffA = (size_t)64 * lda_b, qvoffB = (size_t)64 * ldb_b;
    const size_t kstep = (size_t)(BK * 2);
    const size_t hstepA = (size_t)HALF * lda_b, hstepB = (size_t)HALF * ldb_b;
    const unsigned ldsw = (unsigned)wid * 1024u;
    const int aoff = lds_byte(wr * 64 + fr, fq * 8), boff = lds_byte(wc * 32 + fr, fq * 8);
#define PG8_SA(b, h) (((b) * 2 + (h)) * HTB)
#define PG8_SB(b, h) ((4 + (b) * 2 + (h)) * HTB)
#define PG8_STAGE(bufoff, gbase, voff) do { _Pragma("unroll") for (int _i = 0; _i < 2; ++_i) \
        __builtin_amdgcn_global_load_lds((const unsigned*)((const char*)(gbase) + _i * q##voff + (voff)), (LAS unsigned*)(lds + (bufoff) + ldsw + _i * 8192), 16, 0, 0); } while (0)
#define PG8_LDA(dst, b, h) do { _Pragma("unroll") for (int m = 0; m < 4; ++m) { const v4i_t lo_ = *(const LAS v4i_t*)(lds + PG8_SA(b, h) + aoff + m * 2048), hi_ = *(const LAS v4i_t*)(lds + PG8_SA(b, h) + aoff + m * 2048 + 1024); \
        dst[m] = __builtin_shufflevector(lo_, hi_, 0, 1, 2, 3, 4, 5, 6, 7); } } while (0)
#define PG8_LDB(dst, b, h) do { _Pragma("unroll") for (int n = 0; n < 2; ++n) { const v4i_t lo_ = *(const LAS v4i_t*)(lds + PG8_SB(b, h) + boff + n * 2048), hi_ = *(const LAS v4i_t*)(lds + PG8_SB(b, h) + boff + n * 2048 + 1024); \
        dst[n] = __builtin_shufflevector(lo_, hi_, 0, 1, 2, 3, 4, 5, 6, 7); } } while (0)
#define PG8_LO(v) __builtin_bit_cast(bf16x8, __builtin_shufflevector(v, v, 0, 1, 2, 3))
#define PG8_HI(v) __builtin_bit_cast(bf16x8, __builtin_shufflevector(v, v, 4, 5, 6, 7))
#define PG8_MMA(ai, bj, At, Bt) do { __builtin_amdgcn_s_setprio(1); _Pragma("unroll") for (int m = 0; m < 4; ++m) _Pragma("unroll") for (int n = 0; n < 2; ++n) { if constexpr (FP8) { \
        acc[ai][bj][m][n] = __builtin_amdgcn_mfma_scale_f32_16x16x128_f8f6f4(Bt[n], At[m], acc[ai][bj][m][n], 0, 0, 0, 0, 0, 0); } else { \
        acc[ai][bj][m][n] = __builtin_amdgcn_mfma_f32_16x16x32_bf16(PG8_LO(Bt[n]), PG8_LO(At[m]), acc[ai][bj][m][n], 0, 0, 0); \
        acc[ai][bj][m][n] = __builtin_amdgcn_mfma_f32_16x16x32_bf16(PG8_HI(Bt[n]), PG8_HI(At[m]), acc[ai][bj][m][n], 0, 0, 0); } } __builtin_amdgcn_s_setprio(0); } while (0)
#define PG8_WAIT_V(n) asm volatile("s_waitcnt vmcnt(" #n ")" ::: "memory")
#define PG8_WAIT_L(n) asm volatile("s_waitcnt lgkmcnt(" #n ")" ::: "memory")
#define PG8_BAR __builtin_amdgcn_s_barrier()
#define PG8_SCHED __builtin_amdgcn_sched_barrier(0)
    Unit cur, nxt; int ui = 0;
    if (!S.next(0, cur)) return;
    int ntu = nt;
    if constexpr (Sched::VAR_K) ntu = S.ktiles(cur, nt);
    f32x4 acc[2][2][4][2];
#pragma unroll
    for (int a = 0; a < 2; ++a)
#pragma unroll
        for (int b = 0; b < 2; ++b)
#pragma unroll
            for (int m = 0; m < 4; ++m)
#pragma unroll
                for (int n = 0; n < 2; ++n) acc[a][b][m][n] = (f32x4){0.f, 0.f, 0.f, 0.f};
    v8i_t At[4], B0[2], B1[2];
    const char* cA = cur.A; const char* cB = cur.B;
    if constexpr (SEG) { E.seg_prepare(cur, 0, tid); asm volatile("s_waitcnt lgkmcnt(0)" ::: "memory"); }
#if PG8_SP2
    PG8_STAGE(PG8_SB(0, 0), cB, voffB); PG8_STAGE(PG8_SB(0, 1), cB + hstepB, voffB); PG8_STAGE(PG8_SA(0, 0), cA, voffA); PG8_STAGE(PG8_SA(0, 1), cA + hstepA, voffA);
    if (wr == 1) PG8_BAR;
    PG8_WAIT_V(2); PG8_BAR;
#else
    PG8_STAGE(PG8_SB(0, 0), cB, voffB); PG8_STAGE(PG8_SA(0, 0), cA, voffA); PG8_STAGE(PG8_SB(0, 1), cB + hstepB, voffB); PG8_STAGE(PG8_SA(0, 1), cA + hstepA, voffA);
    if (wr == 1) PG8_BAR;
    PG8_WAIT_V(4); PG8_BAR;
#endif
    PG8_STAGE(PG8_SB(1, 0), cB + kstep, voffB); PG8_STAGE(PG8_SA(1, 0), cA + kstep, voffA); PG8_STAGE(PG8_SB(1, 1), cB + hstepB + kstep, voffB);
    PG8_WAIT_V(6); PG8_BAR;
    for (;;) {
        const bool has_next = S.next(ui + 1, nxt);
        const char* nA = has_next ? nxt.A : cA; const char* nB = has_next ? nxt.B : cB;
#pragma unroll 1
        for (int t = 0; t < ntu; t += 2) {
            const bool last = (t == ntu - 2);
            if constexpr (SEG) { if (t > 0 && (t & (nt / 4 - 1)) == 0) { const LAS float* tb = E.seg_tab(ui & 1) + (t / (nt / 4) - 1);
#pragma unroll
                for (int a = 0; a < 2; ++a)
#pragma unroll
                    for (int m = 0; m < 4; ++m) { const float rt = tb[(128 * a + 64 * wr + 16 * m + fr) * 4];
#pragma unroll
                        for (int b = 0; b < 2; ++b)
#pragma unroll
                            for (int n = 0; n < 2; ++n) acc[a][b][m][n] *= rt; } } }
            const char* a1 = cA + (size_t)(t + 1) * kstep;
            const char* a2 = last ? nA : cA + (size_t)(t + 2) * kstep; const char* b2 = last ? nB : cB + (size_t)(t + 2) * kstep;
            const char* a3 = a2 + kstep; const char* b3 = b2 + kstep;
#if PG8_SP2
            PG8_LDB(B0, 0, 0); PG8_LDB(B1, 0, 1); PG8_SCHED; PG8_LDA(At, 0, 0); PG8_STAGE(PG8_SA(1, 1), a1 + hstepA, voffA);
            PG8_WAIT_V(8); PG8_WAIT_L(0); PG8_BAR; PG8_MMA(0, 0, At, B0); PG8_MMA(0, 1, At, B1); PG8_BAR; PG8_SCHED;
            PG8_LDA(At, 0, 1); PG8_STAGE(PG8_SB(0, 0), b2, voffB); PG8_STAGE(PG8_SB(0, 1), b2 + hstepB, voffB); PG8_STAGE(PG8_SA(0, 0), a2, voffA);
            PG8_WAIT_V(8); PG8_WAIT_L(0); PG8_BAR; PG8_MMA(1, 0, At, B0); PG8_MMA(1, 1, At, B1); PG8_BAR; PG8_SCHED;
            PG8_LDB(B0, 1, 0); PG8_LDB(B1, 1, 1); PG8_SCHED; PG8_LDA(At, 1, 0); PG8_STAGE(PG8_SA(0, 1), a2 + hstepA, voffA);
            PG8_WAIT_V(8); PG8_WAIT_L(0); PG8_BAR; PG8_MMA(0, 0, At, B0); PG8_MMA(0, 1, At, B1); PG8_BAR; PG8_SCHED;
            PG8_LDA(At, 1, 1); PG8_STAGE(PG8_SB(1, 0), b3, voffB); PG8_STAGE(PG8_SB(1, 1), b3 + hstepB, voffB); PG8_STAGE(PG8_SA(1, 0), a3, voffA);
            PG8_WAIT_V(8); PG8_WAIT_L(0); PG8_BAR; PG8_MMA(1, 0, At, B0); PG8_MMA(1, 1, At, B1); PG8_BAR; PG8_SCHED;
#else
            PG8_LDB(B0, 0, 0); PG8_SCHED; PG8_LDA(At, 0, 0); PG8_STAGE(PG8_SA(1, 1), a1 + hstepA, voffA);
            PG8_WAIT_L(8); PG8_BAR; PG8_WAIT_L(0); PG8_MMA(0, 0, At, B0); PG8_BAR; PG8_SCHED;
            PG8_LDB(B1, 0, 1); PG8_STAGE(PG8_SB(0, 0), b2, voffB);
            PG8_BAR; PG8_WAIT_L(0); PG8_MMA(0, 1, At, B1); PG8_BAR;
            PG8_LDA(At, 0, 1); PG8_STAGE(PG8_SA(0, 0), a2, voffA);
            PG8_BAR; PG8_WAIT_L(0); PG8_MMA(1, 0, At, B0); PG8_BAR; PG8_SCHED;
            PG8_STAGE(PG8_SB(0, 1), b2 + hstepB, voffB);
            PG8_WAIT_V(6); PG8_BAR; PG8_MMA(1, 1, At, B1); PG8_BAR;
            PG8_LDB(B0, 1, 0); PG8_SCHED; PG8_LDA(At, 1, 0); PG8_STAGE(PG8_SA(0, 1), a2 + hstepA, voffA);
            PG8_WAIT_L(8); PG8_BAR; PG8_WAIT_L(0); PG8_MMA(0, 0, At, B0); PG8_BAR; PG8_SCHED;
            PG8_LDB(B1, 1, 1); PG8_STAGE(PG8_SB(1, 0), b3, voffB);
            PG8_BAR; PG8_WAIT_L(0); PG8_MMA(0, 1, At, B1); PG8_BAR;
            PG8_LDA(At, 1, 1); PG8_STAGE(PG8_SA(1, 0), a3, voffA);
            PG8_BAR; PG8_WAIT_L(0); PG8_MMA(1, 0, At, B0); PG8_BAR; PG8_SCHED;
            PG8_STAGE(PG8_SB(1, 1), b3 + hstepB, voffB);
            PG8_WAIT_V(6); PG8_BAR; PG8_MMA(1, 1, At, B1); PG8_BAR;
#endif
        }
        if (wr == 0) PG8_BAR;
        { const int le = lane_id(); if constexpr (SEG) E(acc, cur, wr, wc, le & 15, le >> 4, ui & 1); else E(acc, cur, wr, wc, le & 15, le >> 4); }
        if (!has_next) break;
#pragma unroll
        for (int a = 0; a < 2; ++a)
#pragma unroll
            for (int b = 0; b < 2; ++b)
#pragma unroll
                for (int m = 0; m < 4; ++m)
#pragma unroll
                    for (int n = 0; n < 2; ++n) acc[a][b][m][n] = (f32x4){0.f, 0.f, 0.f, 0.f};
        cur = nxt; cA = nA; cB = nB; ++ui;
        if constexpr (Sched::VAR_K) ntu = S.ktiles(cur, nt);
        if constexpr (SEG) { E.seg_prepare(cur, ui & 1, tid); asm volatile("s_waitcnt lgkmcnt(0)" ::: "memory"); }
        if (wr == 1) PG8_BAR;
    }
    PG8_WAIT_V(0);
    PG8_BAR;
#undef PG8_SA
#undef PG8_SB
#undef PG8_STAGE
#undef PG8_LDA
#undef PG8_LDB
#undef PG8_MMA
#undef PG8_LO
#undef PG8_HI
#undef PG8_WAIT_V
#undef PG8_WAIT_L
#undef PG8_BAR
#undef PG8_SCHED
}
}
#define XB_TMO      128
#define XB_XCNT(j)  (256  + 64 * (j))
#define XB_XSUB(j)  (1280 + 64 * (j))
#define XB_XGEN(j)  (2304 + 64 * (j))
#define XB_TOP      3328
#define XB_TOPGEN   3392
#define XCD_BAR_WORDS 3456
#define XB_SPIN_CAP (1u << 18)

__device__ __forceinline__ unsigned xb_ld(unsigned* p)              { return __hip_atomic_load(p, __ATOMIC_RELAXED, __HIP_MEMORY_SCOPE_AGENT); }
__device__ __forceinline__ unsigned xb_add(unsigned* p, unsigned v) { return __hip_atomic_fetch_add(p, v, __ATOMIC_RELAXED, __HIP_MEMORY_SCOPE_AGENT); }
__device__ __forceinline__ unsigned xb_xcc_id() { return (unsigned)__builtin_amdgcn_s_getreg((3 << 11) | 20) & 0xFu; }
#define XB_SPIN(cond, bar) do { unsigned _sp = 0; while (cond) { __builtin_amdgcn_s_sleep(1); \
    if ((++_sp & 255u) == 0u) { if (xb_ld(&(bar)[XB_TMO])) break; if (_sp > XB_SPIN_CAP) { atomicAdd(&(bar)[XB_TMO], 1u); break; } } } } while (0)

struct XcdBarrier {
    unsigned* bar; unsigned x;
    volatile LAS unsigned* st;
};

__device__ __forceinline__ XcdBarrier xcd_barrier_post(unsigned* bar, volatile LAS unsigned* st, const bool thread0) {
    XcdBarrier b; b.bar = bar; b.x = xb_xcc_id(); b.st = st;
    if (thread0) (void)xb_add(&bar[XB_XCNT(b.x)], 1u);
    return b;
}
__device__ __forceinline__ void xcd_barrier_complete(unsigned* bar, unsigned x, unsigned& nloc, unsigned& nx) {
    const unsigned G = gridDim.x * gridDim.y * gridDim.z;
    unsigned sum, cnt, mine, sp = 0u;
    for (;;) {
        sum = 0u; cnt = 0u; mine = 0u;
#pragma unroll
        for (unsigned j = 0; j < 16; ++j) { const unsigned c = xb_ld(&bar[XB_XCNT(j)]); sum += c; cnt += (c > 0u) ? 1u : 0u; mine = (j == x) ? c : mine; }
        if (sum == G) break;
        __builtin_amdgcn_s_sleep(1);
        if ((++sp & 255u) == 0u) { if (xb_ld(&bar[XB_TMO])) break; if (sp > XB_SPIN_CAP) { atomicAdd(&bar[XB_TMO], 1u); break; } }
    }
    nloc = mine > 0u ? mine : 1u; nx = cnt > 0u ? cnt : 1u;
}

__device__ __forceinline__ void xcd_barrier(const XcdBarrier& b, const bool thread0) {
    asm volatile("s_waitcnt vmcnt(0)" ::: "memory");
    __syncthreads();
    if (thread0) {
        unsigned* bar = b.bar;
        __builtin_amdgcn_s_waitcnt(0);
        unsigned nloc = b.st[0], nx = b.st[1];
        if (nloc == 0u) { xcd_barrier_complete(bar, b.x, nloc, nx); b.st[0] = nloc; b.st[1] = nx; }
        const unsigned old = xb_add(&bar[XB_XSUB(b.x)], 1u);
        const unsigned gen = old / nloc;
        if (old + 1u == (gen + 1u) * nloc) {
            __builtin_amdgcn_fence(__ATOMIC_RELEASE, "agent");
            asm volatile("s_waitcnt vmcnt(0)" ::: "memory");
            const unsigned og = xb_add(&bar[XB_TOP], 1u);
            const unsigned tg = og / nx;
            if (og + 1u == (tg + 1u) * nx) xb_add(&bar[XB_TOPGEN], 1u);
            else XB_SPIN(xb_ld(&bar[XB_TOPGEN]) == tg, bar);
            __builtin_amdgcn_fence(__ATOMIC_ACQUIRE, "agent");
            xb_add(&bar[XB_XGEN(b.x)], 1u);
            asm volatile("s_waitcnt vmcnt(0)" ::: "memory");
        } else {
            XB_SPIN(xb_ld(&bar[XB_XGEN(b.x)]) == gen, bar);
            __builtin_amdgcn_fence(__ATOMIC_ACQUIRE, "agent");
            asm volatile("s_waitcnt vmcnt(0)" ::: "memory");
        }
    }
    __syncthreads();
}
struct Ctx { LAS unsigned char* lds; int tid, lane, wave, G, gw, NGW; int rot; };
#define PHASE_CTX(C0) Ctx C = (C0); C.rot = 0; { int t_ = TID_FROM_WAVE(C.wave); asm volatile("" : "+v"(t_)); C.tid = t_; C.lane = t_ & 63; }

DI int p8(int l) { return 16 * ((l >> 2) & 1) + 4 * (l >> 3) + (l & 3); }
enum { MAP_NAT = 0, MAP_P8 = 1, MAP_HEAD64 = 2, MAP_GU_GATE = 3, MAP_GU_UP = 4 };
template <int MAP> DI int map_base(int n0) {
    if (MAP == MAP_HEAD64) return ((n0 >> 8) << 8) + (((n0 >> 5) & 1) << 7) + (((n0 >> 6) & 3) << 5);
    if (MAP == MAP_GU_GATE) return ((n0 >> 7) << 8) + (((n0 >> 5) & 3) << 5);
    if (MAP == MAP_GU_UP) return ((n0 >> 7) << 8) + 128 + (((n0 >> 5) & 3) << 5);
    return n0;
}
DI void cvt_item(const float* W, int ldw, int c0, int k0, bf16_t* WT, int K, int drow0, bool perm, LAS float* scr, int lane, const float* kscale = nullptr) {
#pragma unroll 8
    for (int i = 0; i < 32; ++i) { const int kk = 2 * i + (lane >> 5); float v = W[(size_t)(k0 + kk) * ldw + c0 + (lane & 31)]; if (kscale) v *= kscale[k0 + kk]; scr[kk * 33 + (lane & 31)] = v; }
    LDS_WAIT(); asm volatile("" ::: "memory");
    const int c = lane & 7;
#pragma unroll
    for (int j = 0; j < 4; ++j) { const int n = (lane >> 3) + 8 * j; const LAS float* s = scr + (8 * c) * 33 + n;
        u32x4 o; o.x = pk2(s[0 * 33], s[1 * 33]); o.y = pk2(s[2 * 33], s[3 * 33]); o.z = pk2(s[4 * 33], s[5 * 33]); o.w = pk2(s[6 * 33], s[7 * 33]);
        const int dr = drow0 + (perm ? p8(n) : n);
        *(GAS u32x4*)(WT + (size_t)dr * K + k0 + 8 * c) = o; }
    LDS_WAIT(); asm volatile("" ::: "memory");
}
template <int MAP> DI void cvt_job(Ctx& C, const float* W, int K, int ldw, int col0, int ncols, bf16_t* WT, int dbase, const float* kscale = nullptr) {
    LAS float* scr = (LAS float*)(C.lds + C.wave * 8448);
    const int nblk = ncols >> 5, nitems = (K >> 6) * nblk;
    int it0 = C.gw - C.rot; if (it0 < 0) it0 += C.NGW; C.rot = (C.rot + nitems) % C.NGW;
    for (int it = it0; it < nitems; it += C.NGW) { const int kb = it / nblk, nb = it - kb * nblk;
        cvt_item(W, ldw, col0 + 32 * nb, 64 * kb, WT, K, dbase + map_base<MAP>(32 * nb), MAP != MAP_NAT, scr, C.lane, kscale); }
}
DI void cvt_item8(const float* W, int ldw, int c0, int k0, unsigned char* WT, int K, int drow0, bool perm, LAS float* scr, int lane) {
#pragma unroll 8
    for (int i = 0; i < 32; ++i) { const int kk = 2 * i + (lane >> 5); scr[kk * 33 + (lane & 31)] = W[(size_t)(k0 + kk) * ldw + c0 + (lane & 31)]; }
    LDS_WAIT(); asm volatile("" ::: "memory");
    const int c = lane & 3;
#pragma unroll
    for (int j = 0; j < 2; ++j) { const int n = (lane >> 2) + 16 * j; const LAS float* s = scr + (16 * c) * 33 + n;
        u32x4 o;
        o.x = pk4_fp8(s[0 * 33] * MOE_WSCALE, s[1 * 33] * MOE_WSCALE, s[2 * 33] * MOE_WSCALE, s[3 * 33] * MOE_WSCALE); o.y = pk4_fp8(s[4 * 33] * MOE_WSCALE, s[5 * 33] * MOE_WSCALE, s[6 * 33] * MOE_WSCALE, s[7 * 33] * MOE_WSCALE);
        o.z = pk4_fp8(s[8 * 33] * MOE_WSCALE, s[9 * 33] * MOE_WSCALE, s[10 * 33] * MOE_WSCALE, s[11 * 33] * MOE_WSCALE); o.w = pk4_fp8(s[12 * 33] * MOE_WSCALE, s[13 * 33] * MOE_WSCALE, s[14 * 33] * MOE_WSCALE, s[15 * 33] * MOE_WSCALE);
        *(GAS u32x4*)(WT + (size_t)(drow0 + (perm ? p8(n) : n)) * K + k0 + 16 * c) = o; }
    LDS_WAIT(); asm volatile("" ::: "memory");
}
template <int MAP> DI void cvt_job8(Ctx& C, const float* W, int K, int ldw, int col0, int ncols, unsigned char* WT) {
    LAS float* scr = (LAS float*)(C.lds + C.wave * 8448);
    const int nblk = ncols >> 5, nitems = (K >> 6) * nblk;
    int it0 = C.gw - C.rot; if (it0 < 0) it0 += C.NGW; C.rot = (C.rot + nitems) % C.NGW;
    for (int it = it0; it < nitems; it += C.NGW) { const int kb = it / nblk, nb = it - kb * nblk;
        cvt_item8(W, ldw, col0 + 32 * nb, 64 * kb, WT, K, map_base<MAP>(32 * nb), MAP != MAP_NAT, scr, C.lane); }
}
DI void rms_row_to_bf16(const float* xrow, const float* gain, bf16_t* orow, int lane) {
    const GAS f32x4* xr = (const GAS f32x4*)xrow + lane; const GAS f32x4* gr = (const GAS f32x4*)gain + lane;
    f32x4 v[4]; float s = 0.f;
#pragma unroll
    for (int j = 0; j < 4; ++j) { v[j] = xr[64 * j]; s += (v[j].x * v[j].x + v[j].y * v[j].y) + (v[j].z * v[j].z + v[j].w * v[j].w); }
    const float rstd = __builtin_amdgcn_rsqf(wave_sum(s) * (1.f / 1024.f) + EPS);
    GAS u32x2* o8 = (GAS u32x2*)orow + lane;
#pragma unroll
    for (int j = 0; j < 4; ++j) { const f32x4 g = gr[64 * j]; u32x2 w; w.x = pk2(v[j].x * rstd * g.x, v[j].y * rstd * g.y); w.y = pk2(v[j].z * rstd * g.z, v[j].w * rstd * g.w); o8[64 * j] = w; }
}

template <int NR> DI void rms_rows_to_bf16(const float* x, const float* gain, bf16_t* o, int m0, int rstride, int lane) {
    f32x4 v[NR][4]; float s[NR];
#pragma unroll
    for (int i = 0; i < NR; ++i) { const GAS f32x4* xr = (const GAS f32x4*)(x + (size_t)(m0 + i * rstride) * DM) + lane;
#pragma unroll
        for (int j = 0; j < 4; ++j) v[i][j] = xr[64 * j]; }
    const GAS f32x4* gr = (const GAS f32x4*)gain + lane; f32x4 g[4];
#pragma unroll
    for (int j = 0; j < 4; ++j) g[j] = gr[64 * j];
#pragma unroll
    for (int i = 0; i < NR; ++i) { float a = 0.f;
#pragma unroll
        for (int j = 0; j < 4; ++j) a += dot4f(v[i][j]);
        s[i] = __builtin_amdgcn_rsqf(wave_sum(a) * (1.f / 1024.f) + EPS); }
#pragma unroll
    for (int i = 0; i < NR; ++i) { GAS u32x2* o8 = (GAS u32x2*)(o + (size_t)(m0 + i * rstride) * DM) + lane;
#pragma unroll
        for (int j = 0; j < 4; ++j) { const f32x4 t = v[i][j] * s[i] * g[j]; u32x2 w; w.x = pk2(t[0], t[1]); w.y = pk2(t[2], t[3]); o8[64 * j] = w; } }
}
DI void rms_row_to_fp8(const float* xrow, const float* gain, unsigned char* orow, int lane) {
    const GAS f32x4* xr = (const GAS f32x4*)xrow + lane; const GAS f32x4* gr = (const GAS f32x4*)gain + lane;
    f32x4 v[4]; float s = 0.f;
#pragma unroll
    for (int j = 0; j < 4; ++j) { v[j] = xr[64 * j]; s += (v[j].x * v[j].x + v[j].y * v[j].y) + (v[j].z * v[j].z + v[j].w * v[j].w); }
    const float rstd = __builtin_amdgcn_rsqf(wave_sum(s) * (1.f / 1024.f) + EPS);
    GAS unsigned* o4 = (GAS unsigned*)orow + lane;
#pragma unroll
    for (int j = 0; j < 4; ++j) { const f32x4 g = gr[64 * j]; o4[64 * j] = pk4_fp8(v[j].x * rstd * g.x, v[j].y * rstd * g.y, v[j].z * rstd * g.z, v[j].w * rstd * g.w); }
}
DI void p0_prologue(const Params& P, const Ctx& C0) {
    PHASE_CTX(C0);
    bf16_t* WS = (bf16_t*)(P.ws + WS_WSMALL);
    cvt_job<MAP_HEAD64>(C, P.hy_w_in, 1024, 2048, 0, 512, WS + WO_HYIN, 0);
    cvt_job<MAP_HEAD64>(C, P.hy_w_in, 1024, 2048, 512, 512, WS + WO_HYIN, 512);
    cvt_job<MAP_P8>(C, P.hy_w_in, 1024, 2048, 1536, 512, WS + WO_HYIN, 1024);
    cvt_job<MAP_NAT>(C, P.hy_w_in, 1024, 2048, 1024, 512, WS + WO_HYV, 0);
    cvt_job<MAP_P8>(C, P.hy_w_out, 1024, 1024, 0, 1024, WS + WO_HYOUT, 0);
    unsigned char* W8 = P.ws + WS_W8;
    for (int l = 0; l < 2; ++l) {
#if XA_FP8
        cvt_job8<MAP_P8>(C, P.xa_wq + (size_t)l * 1024 * 1024, 1024, 1024, 0, 1024, W8 + W8_XAQ + (size_t)l * 1024 * 1024);
        cvt_job8<MAP_P8>(C, P.xa_wkv + (size_t)l * 1024 * 2048, 1024, 2048, 0, 1024, W8 + W8_XAK + (size_t)l * 1024 * 1024);
        cvt_job8<MAP_NAT>(C, P.xa_wkv + (size_t)l * 1024 * 2048, 1024, 2048, 1024, 1024, W8 + W8_XAV + (size_t)l * 1024 * 1024);
        cvt_job8<MAP_P8>(C, P.xa_wo + (size_t)l * 1024 * 1024, 1024, 1024, 0, 1024, W8 + W8_XAO + (size_t)l * 1024 * 1024);
#else
        cvt_job<MAP_P8>(C, P.xa_wq + (size_t)l * 1024 * 1024, 1024, 1024, 0, 1024, (bf16_t*)(W8 + W8_XAQ) + (size_t)l * 1024 * 1024, 0);
        cvt_job<MAP_P8>(C, P.xa_wkv + (size_t)l * 1024 * 2048, 1024, 2048, 0, 1024, (bf16_t*)(W8 + W8_XAK) + (size_t)l * 1024 * 1024, 0);
        cvt_job<MAP_NAT>(C, P.xa_wkv + (size_t)l * 1024 * 2048, 1024, 2048, 1024, 1024, (bf16_t*)(W8 + W8_XAV) + (size_t)l * 1024 * 1024, 0);
        cvt_job<MAP_P8>(C, P.xa_wo + (size_t)l * 1024 * 1024, 1024, 1024, 0, 1024, (bf16_t*)(W8 + W8_XAO) + (size_t)l * 1024 * 1024, 0);
#endif
    }
#if FFN_FP8
    cvt_job8<MAP_GU_GATE>(C, P.ffn_wg, 1024, DFF, 0, DFF, W8 + W8_FGU);
    cvt_job8<MAP_GU_UP>(C, P.ffn_wu, 1024, DFF, 0, DFF, W8 + W8_FGU);
    cvt_job8<MAP_P8>(C, P.ffn_wd, DFF, 1024, 0, 1024, W8 + W8_FDN);
#else
    cvt_job<MAP_GU_GATE>(C, P.ffn_wg, 1024, DFF, 0, DFF, (bf16_t*)(W8 + W8_FGU), 0);
    cvt_job<MAP_GU_UP>(C, P.ffn_wu, 1024, DFF, 0, DFF, (bf16_t*)(W8 + W8_FGU), 0);
    cvt_job<MAP_P8>(C, P.ffn_wd, DFF, 1024, 0, 1024, (bf16_t*)(W8 + W8_FDN), 0);
#endif
    cvt_job<MAP_P8>(C, P.ssd_w_in, 1024, 5152, 0, 5120, WS + WO_SIN, 0);
    cvt_job<MAP_NAT>(C, P.ssd_w_in, 1024, 5152, 5120, 32, WS + WO_SIN, 5120);
    cvt_job<MAP_P8>(C, P.ssd_w_out, 2048, 1024, 0, 1024, WS + WO_SOUT, 0, P.ssd_norm);
    for (int g = 0; g < 4; ++g) cvt_job<MAP_NAT>(C, P.pool_w + (size_t)g * 16384, 128, 128, 0, 128, (bf16_t*)(P.ws + WS_WPOOL) + (size_t)g * 16384, 0);
    {
        GAS u32x4* z = (GAS u32x4*)(WS + WO_SIN + (size_t)5152 * 1024); const int n16 = 224 * 1024 * 2 / 16;
        for (int i = blockIdx.x * NTHR + C.tid; i < n16; i += C.G * NTHR) z[i] = (u32x4){0u, 0u, 0u, 0u};
    }
    {
        float* rope = (float*)(P.ws + WS_ROPE);
        for (int i = blockIdx.x * NTHR + C.tid; i < SEQ * 32; i += C.G * NTHR) { const int s = i >> 5, d = i & 31;
            const float inv = exp2f(-(float)d * (13.287712379549449f / 32.f)); const float ang = (float)P.pos[s] * inv;
            float sn, cs; sincosf(ang, &sn, &cs); rope[s * 64 + d] = cs; rope[s * 64 + 32 + d] = sn; }
    }
    bf16_t* hnA = (bf16_t*)(P.ws + WS_HNA); unsigned char* memn = P.ws + WS_MEMN;
    for (int m = C.gw; m < NTOK; m += 4 * C.NGW) rms_rows_to_bf16<4>(P.x, P.mix_norm, hnA, m, C.NGW, C.lane);
    for (int m = C.gw; m < 2 * NBATCH * NMEM; m += C.NGW) { const int l = m >> 11, r = m & 2047;
        if (XA_FP8) rms_row_to_fp8(P.mem + (size_t)r * DM, P.mem_norm + l * DM, memn + (size_t)m * DM, C.lane);
        else rms_row_to_bf16(P.mem + (size_t)r * DM, P.mem_norm + l * DM, (bf16_t*)memn + (size_t)m * DM, C.lane); }
}
template <bool DOWN> DI void moe_weight_cvt(const Params& P, const Ctx& C0) {
    PHASE_CTX(C0);
    unsigned char* WM = P.ws + WS_WMOE8;
    for (int e = 0; e < NEXP; ++e) {
        if constexpr (!DOWN) {
            cvt_job8<MAP_GU_GATE>(C, P.moe_wg + (size_t)e * 1024 * DFE, 1024, DFE, 0, DFE, WM + WM8_GU + (size_t)e * 7168 * 1024);
            cvt_job8<MAP_GU_UP>(C, P.moe_wu + (size_t)e * 1024 * DFE, 1024, DFE, 0, DFE, WM + WM8_GU + (size_t)e * 7168 * 1024);
        } else cvt_job8<MAP_P8>(C, P.moe_wd + (size_t)e * DFE * 1024, DFE, 1024, 0, 1024, WM + WM8_DN + (size_t)e * 1024 * DFE);
    }
}
typedef f32x4 Acc[2][2][4][2];
DI u32x4 pack8(const f32x4& a, const f32x4& b) { u32x4 w; w.x = pk2(a[0], a[1]); w.y = pk2(a[2], a[3]); w.z = pk2(b[0], b[1]); w.w = pk2(b[2], b[3]); return w; }
DI u32x2 pack4(const f32x4& a) { u32x2 w; w.x = pk2(a[0], a[1]); w.y = pk2(a[2], a[3]); return w; }
DI float dot4(const f32x4& a) { return (a[0] * a[0] + a[1] * a[1]) + (a[2] * a[2] + a[3] * a[3]); }
DI float rstd_from_ss(const float* ss, int row, int fq) {
    const f32x4 t = *(const GAS f32x4*)(ss + (size_t)row * 16 + 4 * fq); float s = (t[0] + t[1]) + (t[2] + t[3]);
    s += shx(s, 16); s += shx(s, 32);
    return __builtin_amdgcn_rsqf(s * (1.f / 1024.f) + EPS);
}

DI void rstd8_from_ss(const float* ss, int row0, int wr, int fr, int fq, float (&rs)[2][4]) {
    f32x4 t[2][4];
#pragma unroll
    for (int ai = 0; ai < 2; ++ai)
#pragma unroll
        for (int m = 0; m < 4; ++m) t[ai][m] = *(const GAS f32x4*)(ss + (size_t)(row0 + 128 * ai + 64 * wr + 16 * m + fr) * 16 + 4 * fq);
#pragma unroll
    for (int ai = 0; ai < 2; ++ai)
#pragma unroll
        for (int m = 0; m < 4; ++m) { float s = (t[ai][m][0] + t[ai][m][1]) + (t[ai][m][2] + t[ai][m][3]); s += shx(s, 16); s += shx(s, 32); rs[ai][m] = __builtin_amdgcn_rsqf(s * (1.f / 1024.f) + EPS); }
}
DI void rows8_from_tab(const float* tab, int row0, int wr, int fr, float (&rs)[2][4]) {
#pragma unroll
    for (int ai = 0; ai < 2; ++ai)
#pragma unroll
        for (int m = 0; m < 4; ++m) rs[ai][m] = tab[row0 + 128 * ai + 64 * wr + 16 * m + fr];
}

struct EpiHyIn {
    bf16_t* Q; bf16_t* Kb; bf16_t* U; bf16_t* VT; const float* qg; const float* kg; const float* rope; float* kmp;
    DI void operator()(Acc& acc, const pg8::Unit& u, int wr, int wc, int fr, int fq) const {
        if (u.kind <= 1) {
            const float* gain = u.kind == 0 ? qg : kg; bf16_t* dst = u.kind == 0 ? Q : Kb; const float osc = u.kind == 0 ? 0.125f * 1.4426950408889634f : 1.f;
            f32x4 gv[2][2];
#pragma unroll
            for (int bj = 0; bj < 2; ++bj)
#pragma unroll
                for (int n = 0; n < 2; ++n) gv[bj][n] = *(const GAS f32x4*)(gain + 32 * bj + 8 * fq + 4 * n);
            f32x4 ks[2][2];
#pragma unroll
            for (int bj = 0; bj < 2; ++bj)
#pragma unroll
                for (int n = 0; n < 2; ++n) ks[bj][n] = (f32x4){0.f, 0.f, 0.f, 0.f};
            const int head = 4 * u.aux + wc;
#pragma unroll
            for (int ai = 0; ai < 2; ++ai)
#pragma unroll
                for (int m = 0; m < 4; ++m) {
                    const int row = u.pm * 256 + 128 * ai + 64 * wr + 16 * m + fr;
                    float s = 0.f;
#pragma unroll
                    for (int bj = 0; bj < 2; ++bj)
#pragma unroll
                        for (int n = 0; n < 2; ++n) s += dot4(acc[ai][bj][m][n]);
                    s += shx(s, 16); s += shx(s, 32);
                    const float r = __builtin_amdgcn_rsqf(s * (1.f / 64.f) + EPS);
                    const float* rp = rope + (size_t)(row & (SEQ - 1)) * 64 + 8 * fq;
                    f32x4 o[2][2];
#pragma unroll
                    for (int n = 0; n < 2; ++n) {
                        const f32x4 c4 = *(const GAS f32x4*)(rp + 4 * n), s4 = *(const GAS f32x4*)(rp + 32 + 4 * n);
                        const f32x4 x1 = acc[ai][0][m][n] * r * gv[0][n], x2 = acc[ai][1][m][n] * r * gv[1][n];
                        o[0][n] = (x1 * c4 - x2 * s4) * osc; o[1][n] = (x2 * c4 + x1 * s4) * osc;
                        ks[0][n] += o[0][n]; ks[1][n] += o[1][n];
                    }
#pragma unroll
                    for (int bj = 0; bj < 2; ++bj) *(GAS u32x4*)(dst + (size_t)row * 512 + head * 64 + 32 * bj + 8 * fq) = pack8(o[bj][0], o[bj][1]);
                }
            if (u.kind == 1) {
#pragma unroll
                for (int bj = 0; bj < 2; ++bj)
#pragma unroll
                    for (int n = 0; n < 2; ++n) {
                        f32x4 v = ks[bj][n];
#pragma unroll
                        for (int o = 1; o < 16; o <<= 1) { v[0] += shx(v[0], o); v[1] += shx(v[1], o); v[2] += shx(v[2], o); v[3] += shx(v[3], o); }
                        if (fr == 0) *(GAS f32x4*)(kmp + (size_t)(u.pm * 2 + wr) * 512 + head * 64 + 32 * bj + 8 * fq + 4 * n) = v;
                    }
            }
        } else if (u.kind == 2) {
#pragma unroll
            for (int ai = 0; ai < 2; ++ai)
#pragma unroll
                for (int m = 0; m < 4; ++m) { const int row = u.pm * 256 + 128 * ai + 64 * wr + 16 * m + fr;
#pragma unroll
                    for (int bj = 0; bj < 2; ++bj) *(GAS u32x4*)(U + (size_t)row * 512 + u.aux * 256 + 128 * bj + 32 * wc + 8 * fq) = pack8(acc[ai][bj][m][0], acc[ai][bj][m][1]); }
        } else {
#pragma unroll
            for (int ai = 0; ai < 2; ++ai)
#pragma unroll
                for (int m = 0; m < 4; ++m) { const int feat = u.pm * 256 + 128 * ai + 64 * wr + 16 * m + fr;
#pragma unroll
                    for (int bj = 0; bj < 2; ++bj)
#pragma unroll
                        for (int n = 0; n < 2; ++n) *(GAS u32x2*)(VT + (size_t)feat * NTOK + u.pn * 256 + 128 * bj + 32 * wc + 16 * n + 4 * fq) = pack4(acc[ai][bj][m][n]); }
        }
    }
};
struct SchedHyIn {
    static constexpr bool VAR_K = false;
    const char* hn; const char* wqku; const char* wv; int G, c;
    DI bool next(int i, pg8::Unit& u) const {
        const int L = i * G + c; if (L >= 1024) return false;
        if (L < 768) { int pm, pn; pg8::tile_of(L, 128, 6, pm, pn); u.A = hn + (size_t)pm * 256 * 2048; u.B = wqku + (size_t)pn * 256 * 2048; u.pm = pm; u.pn = pn; u.kind = pn >> 1; u.aux = pn & 1; }
        else { int pm, pn; pg8::tile_of(L - 768, 2, 128, pm, pn); u.A = wv + (size_t)pm * 256 * 2048; u.B = hn + (size_t)pn * 256 * 2048; u.pm = pm; u.pn = pn; u.kind = 3; u.aux = 0; }
        return true;
    }
};

DI unsigned char* res_at(float* out, int row, int pn) { return (unsigned char*)out + (size_t)row * 4096 + pn * 1024; }
DI u32x4 widen8(const u32x2& w0, const u32x2& w1) {
    const auto rx = __builtin_amdgcn_permlane16_swap(w0.x, w1.x, false, false);
    const auto ry = __builtin_amdgcn_permlane16_swap(w0.y, w1.y, false, false);
    return (u32x4){rx[0], ry[0], rx[1], ry[1]};
}
DI void unpack8(const u32x4& b, f32x4& lo, f32x4& hi) { lo = (f32x4){bflo(b.x), bfhi(b.x), bflo(b.y), bfhi(b.y)}; hi = (f32x4){bflo(b.z), bfhi(b.z), bflo(b.w), bfhi(b.w)}; }
template <bool F8, bool BASEX = false> struct EpiRes {
    const float* base; float* out; void* hAv; const float* gain; float* ss; float asc;
    DI void operator()(Acc& acc, const pg8::Unit& u, int wr, int wc, int fr, int fq) const {
        const int cl = 32 * wc + 8 * fq;
        f32x4 gv[2][2];
#pragma unroll
        for (int bj = 0; bj < 2; ++bj)
#pragma unroll
            for (int n = 0; n < 2; ++n) gv[bj][n] = *(const GAS f32x4*)(gain + u.pn * 256 + 128 * bj + cl + 4 * n);
        u32x4 bb[BASEX ? 1 : 2][BASEX ? 1 : 4][2];
        if constexpr (!BASEX) {
#pragma unroll
            for (int ai = 0; ai < 2; ++ai)
#pragma unroll
                for (int m = 0; m < 4; ++m)
#pragma unroll
                    for (int bj = 0; bj < 2; ++bj) bb[ai][m][bj] = *(const GAS u32x4*)(res_at(out, u.pm * 256 + 128 * ai + 64 * wr + 16 * m + fr, u.pn) + (128 * bj + cl) * 2);
        }
#pragma unroll
        for (int ai = 0; ai < 2; ++ai) {
            f32x4 bx[BASEX ? 4 : 1][2][2];
            if constexpr (BASEX) {
#pragma unroll
                for (int m = 0; m < 4; ++m)
#pragma unroll
                    for (int bj = 0; bj < 2; ++bj)
#pragma unroll
                        for (int n = 0; n < 2; ++n) bx[m][bj][n] = *(const GAS f32x4*)(base + (size_t)(u.pm * 256 + 128 * ai + 64 * wr + 16 * m + fr) * DM + u.pn * 256 + 128 * bj + cl + 4 * n);
            }
            u32x2 wq[2][2];
#pragma unroll
            for (int m = 0; m < 4; ++m) {
                const int row = u.pm * 256 + 128 * ai + 64 * wr + 16 * m + fr; float s = 0.f;
#pragma unroll
                for (int bj = 0; bj < 2; ++bj) {
                    f32x4 h0, h1;
                    if constexpr (BASEX) { h0 = bx[m][bj][0]; h1 = bx[m][bj][1]; } else unpack8(bb[ai][m][bj], h0, h1);
                    h0 += acc[ai][bj][m][0] * asc; h1 += acc[ai][bj][m][1] * asc;
                    *(GAS u32x4*)(res_at(out, row, u.pn) + (128 * bj + cl) * 2) = pack8(h0, h1); s += dot4(h0) + dot4(h1);
                    const size_t o = (size_t)row * DM + u.pn * 256 + 128 * bj + cl; const f32x4 g0 = gv[bj][0], g1 = gv[bj][1];
                    if constexpr (F8) { wq[m & 1][bj].x = pk4_fp8(h0[0] * g0[0], h0[1] * g0[1], h0[2] * g0[2], h0[3] * g0[3]); wq[m & 1][bj].y = pk4_fp8(h1[0] * g1[0], h1[1] * g1[1], h1[2] * g1[2], h1[3] * g1[3]); }
                    else *(GAS u32x4*)((bf16_t*)hAv + o) = pack8(h0 * g0, h1 * g1);
                }
                if constexpr (F8) { if ((m & 1) == 1) { const int rw = u.pm * 256 + 128 * ai + 64 * wr + 16 * (m - 1 + (fq & 1)) + fr;
#pragma unroll
                    for (int bj = 0; bj < 2; ++bj) *(GAS u32x4*)((unsigned char*)hAv + (size_t)rw * DM + u.pn * 256 + 128 * bj + 32 * wc + 8 * (fq & 2)) = widen8(wq[0][bj], wq[1][bj]); } }
                s += shx(s, 16); s += shx(s, 32);
                if (fq == 0) ss[(size_t)row * 16 + u.pn * 4 + wc] = s;
            }
            asm volatile("" ::: "memory");
        }
    }
};
struct EpiResRt {
    const float* base; float* out; void* hAv; const float* gain; float* ss; float asc; const float* router; float* lp;
    DI void operator()(Acc& acc, const pg8::Unit& u, int wr, int wc, int fr, int fq) const {
        float sq[2][4];
#pragma unroll
        for (int ai = 0; ai < 2; ++ai)
#pragma unroll
            for (int m = 0; m < 4; ++m) sq[ai][m] = 0.f;
#pragma unroll
        for (int bj = 0; bj < 2; ++bj) {
            const int cl = 128 * bj + 32 * wc + 8 * fq, col0 = u.pn * 256 + cl;
            f32x4 gv[2];
#pragma unroll
            for (int n = 0; n < 2; ++n) gv[n] = *(const GAS f32x4*)(gain + col0 + 4 * n);
            bf16x8 wh, wl;
            { float w[8];
#pragma unroll
              for (int q = 0; q < 8; ++q) w[q] = router[(size_t)(col0 + q) * 8 + (fr & 7)] * gv[q >> 2][q & 3];
              u32x4 hi, lo; hi.x = pk2(w[0], w[1]); hi.y = pk2(w[2], w[3]); hi.z = pk2(w[4], w[5]); hi.w = pk2(w[6], w[7]);
              lo.x = pk2(w[0] - bflo(hi.x), w[1] - bfhi(hi.x)); lo.y = pk2(w[2] - bflo(hi.y), w[3] - bfhi(hi.y)); lo.z = pk2(w[4] - bflo(hi.z), w[5] - bfhi(hi.z)); lo.w = pk2(w[6] - bflo(hi.w), w[7] - bfhi(hi.w));
              wh = __builtin_bit_cast(bf16x8, hi); wl = __builtin_bit_cast(bf16x8, lo); }
            u32x4 bbq[2][4];
#pragma unroll
            for (int ai = 0; ai < 2; ++ai)
#pragma unroll
                for (int m = 0; m < 4; ++m) bbq[ai][m] = *(const GAS u32x4*)(res_at(out, u.pm * 256 + 128 * ai + 64 * wr + 16 * m + fr, u.pn) + cl * 2);
#pragma unroll
            for (int am = 0; am < 4; ++am) { const int ai = am >> 1;
                u32x2 wq[2]; f32x4 Dp;
#pragma unroll
                for (int m = 2 * (am & 1); m < 2 * (am & 1) + 2; ++m) {
                    const int row = u.pm * 256 + 128 * ai + 64 * wr + 16 * m + fr;
                    f32x4 h[2]; unpack8(bbq[ai][m], h[0], h[1]);
                    h[0] += acc[ai][bj][m][0] * asc; h[1] += acc[ai][bj][m][1] * asc;
                    *(GAS u32x4*)(res_at(out, row, u.pn) + cl * 2) = pack8(h[0], h[1]); sq[ai][m] += dot4(h[0]) + dot4(h[1]);
                    wq[m & 1].x = pk4_fp8(h[0][0] * gv[0][0], h[0][1] * gv[0][1], h[0][2] * gv[0][2], h[0][3] * gv[0][3]); wq[m & 1].y = pk4_fp8(h[1][0] * gv[1][0], h[1][1] * gv[1][1], h[1][2] * gv[1][2], h[1][3] * gv[1][3]);
                    if ((m & 1) == 1) *(GAS u32x4*)((unsigned char*)hAv + (size_t)(u.pm * 256 + 128 * ai + 64 * wr + 16 * (m - 1 + (fq & 1)) + fr) * DM + u.pn * 256 + 128 * bj + 32 * wc + 8 * (fq & 2)) = widen8(wq[0], wq[1]);
                    u32x4 bh, bl; bh.x = pk2(h[0][0], h[0][1]); bh.y = pk2(h[0][2], h[0][3]); bh.z = pk2(h[1][0], h[1][1]); bh.w = pk2(h[1][2], h[1][3]);
                    bl.x = pk2(h[0][0] - bflo(bh.x), h[0][1] - bfhi(bh.x)); bl.y = pk2(h[0][2] - bflo(bh.y), h[0][3] - bfhi(bh.y)); bl.z = pk2(h[1][0] - bflo(bh.z), h[1][1] - bfhi(bh.z)); bl.w = pk2(h[1][2] - bflo(bh.w), h[1][3] - bfhi(bh.w));
                    f32x4 D = {0.f, 0.f, 0.f, 0.f};
                    D = __builtin_amdgcn_mfma_f32_16x16x32_bf16(wh, __builtin_bit_cast(bf16x8, bh), D, 0, 0, 0);
                    D = __builtin_amdgcn_mfma_f32_16x16x32_bf16(wh, __builtin_bit_cast(bf16x8, bl), D, 0, 0, 0);
                    D = __builtin_amdgcn_mfma_f32_16x16x32_bf16(wl, __builtin_bit_cast(bf16x8, bh), D, 0, 0, 0);
                    if ((m & 1) == 0) Dp = D;
                    else { const f32x4 Dv = fq < 2 ? Dp : D; const int rl = u.pm * 256 + 128 * ai + 64 * wr + 16 * (m - 1 + (fq >> 1)) + fr;
                        *(GAS f32x4*)(lp + ((size_t)rl * 32 + (u.pn * 4 + wc) * 2 + bj) * 8 + 4 * (fq & 1)) = Dv; }
                }
                asm volatile("" ::: "memory");
            }
        }
#pragma unroll
        for (int ai = 0; ai < 2; ++ai)
#pragma unroll
            for (int m = 0; m < 4; ++m) { float s = sq[ai][m]; s += shx(s, 16); s += shx(s, 32);
                if (fq == 0) ss[(size_t)(u.pm * 256 + 128 * ai + 64 * wr + 16 * m + fr) * 16 + u.pn * 4 + wc] = s; }
    }
};
struct EpiResSeg {
    const float* base; float* out; void* hAv; const float* gain; float* ss; const float* yss; LAS float* tab;
    DI LAS float* seg_tab(int buf) const { return tab + buf * 1024; }
    DI void seg_prepare(const pg8::Unit& u, int buf, int tid) const {
        if (tid < 256) { const float* yp = yss + (size_t)(u.pm * 256 + tid) * 64; float rs[4];
#pragma unroll
            for (int g = 0; g < 4; ++g) { float a = 0.f;
#pragma unroll
                for (int q = 0; q < 4; ++q) { const f32x4 t = *(const GAS f32x4*)(yp + 16 * g + 4 * q); a += (t[0] + t[1]) + (t[2] + t[3]); }
                rs[g] = __builtin_amdgcn_rsqf(a * (1.f / 512.f) + EPS); }
            *(LAS f32x4*)(seg_tab(buf) + tid * 4) = (f32x4){rs[0] / rs[1], rs[1] / rs[2], rs[2] / rs[3], rs[3]}; }
    }
    DI void operator()(Acc& acc, const pg8::Unit& u, int wr, int wc, int fr, int fq, int buf) const {
        const LAS float* tb = seg_tab(buf) + 3;
        const int cl = 32 * wc + 8 * fq;
        f32x4 gv[2][2];
#pragma unroll
        for (int bj = 0; bj < 2; ++bj)
#pragma unroll
            for (int n = 0; n < 2; ++n) gv[bj][n] = *(const GAS f32x4*)(gain + u.pn * 256 + 128 * bj + cl + 4 * n);
        u32x4 bb[2][4][2];
#pragma unroll
        for (int ai = 0; ai < 2; ++ai)
#pragma unroll
            for (int m = 0; m < 4; ++m)
#pragma unroll
                for (int bj = 0; bj < 2; ++bj) bb[ai][m][bj] = *(const GAS u32x4*)(res_at(out, u.pm * 256 + 128 * ai + 64 * wr + 16 * m + fr, u.pn) + (128 * bj + cl) * 2);
#pragma unroll
        for (int ai = 0; ai < 2; ++ai) {
            u32x2 wq[2][2]; float sv[4];
#pragma unroll
            for (int m = 0; m < 4; ++m) {
                const int rt = 128 * ai + 64 * wr + 16 * m + fr, row = u.pm * 256 + rt; float s = 0.f; const float asc = tb[rt * 4];
#pragma unroll
                for (int bj = 0; bj < 2; ++bj) {
                    f32x4 h0, h1; unpack8(bb[ai][m][bj], h0, h1);
                    h0 += acc[ai][bj][m][0] * asc; h1 += acc[ai][bj][m][1] * asc;
                    *(GAS u32x4*)(res_at(out, row, u.pn) + (128 * bj + cl) * 2) = pack8(h0, h1); s += dot4(h0) + dot4(h1);
                    const size_t o = (size_t)row * DM + u.pn * 256 + 128 * bj + cl; const f32x4 g0 = gv[bj][0], g1 = gv[bj][1];
                    if constexpr (XA_FP8 != 0) { wq[m & 1][bj].x = pk4_fp8(h0[0] * g0[0], h0[1] * g0[1], h0[2] * g0[2], h0[3] * g0[3]); wq[m & 1][bj].y = pk4_fp8(h1[0] * g1[0], h1[1] * g1[1], h1[2] * g1[2], h1[3] * g1[3]); }
                    else *(GAS u32x4*)((bf16_t*)hAv + o) = pack8(h0 * g0, h1 * g1);
                }
                if constexpr (XA_FP8 != 0) { if ((m & 1) == 1) { const int rw = u.pm * 256 + 128 * ai + 64 * wr + 16 * (m - 1 + (fq & 1)) + fr;
#pragma unroll
                    for (int bj = 0; bj < 2; ++bj) *(GAS u32x4*)((unsigned char*)hAv + (size_t)rw * DM + u.pn * 256 + 128 * bj + 32 * wc + 8 * (fq & 2)) = widen8(wq[0][bj], wq[1][bj]); } }
                s += shx(s, 16); s += shx(s, 32); sv[m] = s;
            }
            {
                const float v = fq == 0 ? sv[0] : (fq == 1 ? sv[1] : (fq == 2 ? sv[2] : sv[3]));
                ss[(size_t)(u.pm * 256 + 128 * ai + 64 * wr + 16 * fq + fr) * 16 + u.pn * 4 + wc] = v; }
            asm volatile("" ::: "memory");
        }
    }
};
struct SchedPlain {
    static constexpr bool VAR_K = false;
    const char* A; const char* B; int nM, nN, lda_b, ldb_b, G, c;
    DI bool next(int i, pg8::Unit& u) const {
        const int L = i * G + c; if (L >= nM * nN) return false;
        int pm, pn; pg8::tile_of(L, nM, nN, pm, pn); u.A = A + (size_t)pm * 256 * lda_b; u.B = B + (size_t)pn * 256 * ldb_b; u.pm = pm; u.pn = pn; u.kind = 0; u.aux = 0; return true;
    }
};

struct EpiXaProj {
    bf16_t* Qx; bf16_t* Kx; bf16_t* VTx; const float* qg; const float* kg; const float* ss; LAS float* XS;
    DI void operator()(Acc& acc, const pg8::Unit& u, int wr, int wc, int fr, int fq) const {
        if (u.kind == 2) {
            bf16_t* vt = VTx + (size_t)u.aux * 1024 * 2048;
#pragma unroll
            for (int ai = 0; ai < 2; ++ai)
#pragma unroll
                for (int m = 0; m < 4; ++m) { const int feat = u.pm * 256 + 128 * ai + 64 * wr + 16 * m + fr;
#pragma unroll
                    for (int bj = 0; bj < 2; ++bj)
#pragma unroll
                        for (int n = 0; n < 2; ++n) *(GAS u32x2*)(vt + (size_t)feat * 2048 + u.pn * 256 + 128 * bj + 32 * wc + 16 * n + 4 * fq) = pack4(acc[ai][bj][m][n] * (1.f / XAWS)); }
            return;
        }
        const float* gain = u.kind == 0 ? qg : kg + u.aux * 256;
        bf16_t* dst = u.kind == 0 ? Qx : Kx + (size_t)u.aux * 2048 * 1024;
        const float osc = u.kind == 0 ? 0.0625f : 1.f;
        float rs8[2][4];
        if (u.kind == 0) rstd8_from_ss(ss, u.pm * 256, wr, fr, fq, rs8);
#pragma unroll
        for (int ai = 0; ai < 2; ++ai)
#pragma unroll
            for (int m = 0; m < 4; ++m) {
                const int rt = 128 * ai + 64 * wr + 16 * m + fr;
                float rs = 1.f / XAWS; if (u.kind == 0) rs *= rs8[ai][m];
                float s = 0.f;
#pragma unroll
                for (int bj = 0; bj < 2; ++bj)
#pragma unroll
                    for (int n = 0; n < 2; ++n) { acc[ai][bj][m][n] *= rs; s += dot4(acc[ai][bj][m][n]); }
                s += shx(s, 16); s += shx(s, 32);
                if (fq == 0) XS[rt * 4 + wc] = s;
            }
        LDS_WAIT(); __builtin_amdgcn_s_barrier(); asm volatile("" ::: "memory");
        f32x4 gv[2][2];
#pragma unroll
        for (int bj = 0; bj < 2; ++bj)
#pragma unroll
            for (int n = 0; n < 2; ++n) gv[bj][n] = *(const GAS f32x4*)(gain + 128 * bj + 32 * wc + 8 * fq + 4 * n);
#pragma unroll
        for (int ai = 0; ai < 2; ++ai)
#pragma unroll
            for (int m = 0; m < 4; ++m) {
                const int rt = 128 * ai + 64 * wr + 16 * m + fr;
                const f32x4 t = *(const LAS f32x4*)(XS + rt * 4);
                const float r = __builtin_amdgcn_rsqf(((t[0] + t[1]) + (t[2] + t[3])) * (1.f / 256.f) + EPS) * osc;
#pragma unroll
                for (int bj = 0; bj < 2; ++bj)
                    *(GAS u32x4*)(dst + (size_t)(u.pm * 256 + rt) * DM + u.pn * 256 + 128 * bj + 32 * wc + 8 * fq) = pack8(acc[ai][bj][m][0] * r * gv[bj][0], acc[ai][bj][m][1] * r * gv[bj][1]);
            }
        LDS_WAIT();
    }
};
struct SchedXaProj {
    static constexpr bool VAR_K = false;
    const char* hA; const char* wq; const char* memn; const char* wk; const char* wv; int lq, l0, l1, G, c;
    DI bool next(int i, pg8::Unit& u) const {
        int L = i * G + c; const int ntot = 512 + (l1 - l0) * 64; if (L >= ntot) return false;
        if (L < 512) { int pm, pn; pg8::tile_of(L, 128, 4, pm, pn); u.A = hA + (size_t)pm * 256 * 1024 * XAB; u.B = wq + (size_t)pn * 256 * 1024 * XAB; u.pm = pm; u.pn = pn; u.kind = 0; u.aux = 0; return true; }
        L -= 512; const int l = l0 + L / 64; L %= 64;
        if (L < 32) { const int pm = L >> 2, pn = L & 3; u.A = memn + ((size_t)l * 2048 * 1024 + (size_t)pm * 256 * 1024) * XAB; u.B = wk + ((size_t)l * 1024 * 1024 + (size_t)pn * 256 * 1024) * XAB; u.pm = pm; u.pn = pn; u.kind = 1; u.aux = l; }
        else { L -= 32; const int pm = L >> 3, pn = L & 7; u.A = wv + ((size_t)l * 1024 * 1024 + (size_t)pm * 256 * 1024) * XAB; u.B = memn + ((size_t)l * 2048 * 1024 + (size_t)pn * 256 * 1024) * XAB; u.pm = pm; u.pn = pn; u.kind = 2; u.aux = l; }
        return true;
    }
};

struct EpiXaS {
    bf16_t* Px; float* psum;
    DI void operator()(Acc& acc, const pg8::Unit& u, int wr, int wc, int fr, int fq) const {
#pragma unroll
        for (int ai = 0; ai < 2; ++ai)
#pragma unroll
            for (int m = 0; m < 4; ++m) {
                const int row = u.pm * 256 + 128 * ai + 64 * wr + 16 * m + fr; float s = 0.f;
#pragma unroll
                for (int bj = 0; bj < 2; ++bj) {
                    f32x4 p0, p1;
#pragma unroll
                    for (int j = 0; j < 4; ++j) { p0[j] = __expf(fminf(acc[ai][bj][m][0][j], 80.f)); p1[j] = __expf(fminf(acc[ai][bj][m][1][j], 80.f)); }
                    s += (p0[0] + p0[1]) + (p0[2] + p0[3]) + (p1[0] + p1[1]) + (p1[2] + p1[3]);
                    *(GAS u32x4*)(Px + (size_t)row * DM + u.pn * 256 + 128 * bj + 32 * wc + 8 * fq) = pack8(p0, p1);
                }
                s += shx(s, 16); s += shx(s, 32);
                if (fq == 0) psum[(size_t)row * 16 + u.pn * 4 + wc] = s;
            }
    }
};
struct EpiXaO {
    unsigned char* Ox; const float* psum;
    DI void operator()(Acc& acc, const pg8::Unit& u, int wr, int wc, int fr, int fq) const {
        f32x4 ps[2][4];
#pragma unroll
        for (int ai = 0; ai < 2; ++ai)
#pragma unroll
            for (int m = 0; m < 4; ++m) ps[ai][m] = *(const GAS f32x4*)(psum + (size_t)(u.pm * 256 + 128 * ai + 64 * wr + 16 * m + fr) * 16 + u.pn * 4);
#pragma unroll
        for (int ai = 0; ai < 2; ++ai)
#pragma unroll
            for (int mp = 0; mp < 2; ++mp) {
                u32x2 w[2][2];
#pragma unroll
                for (int mm = 0; mm < 2; ++mm) { const int m = 2 * mp + mm;
                    const int row = u.pm * 256 + 128 * ai + 64 * wr + 16 * m + fr;
                    const f32x4 t = ps[ai][m];
                    const float r = 1.f / ((t[0] + t[1]) + (t[2] + t[3]));
#pragma unroll
                    for (int bj = 0; bj < 2; ++bj) { const f32x4 a0 = acc[ai][bj][m][0] * r, a1 = acc[ai][bj][m][1] * r;
                        if constexpr (XA_FP8 != 0) { w[mm][bj].x = pk4_fp8(a0[0], a0[1], a0[2], a0[3]); w[mm][bj].y = pk4_fp8(a1[0], a1[1], a1[2], a1[3]); }
                        else *(GAS u32x4*)((bf16_t*)Ox + (size_t)row * DM + u.pn * 256 + 128 * bj + 32 * wc + 8 * fq) = pack8(a0, a1); } }
                if constexpr (XA_FP8 != 0) { const int row = u.pm * 256 + 128 * ai + 64 * wr + 16 * (2 * mp + (fq & 1)) + fr;
#pragma unroll
                    for (int bj = 0; bj < 2; ++bj) *(GAS u32x4*)(Ox + (size_t)row * DM + u.pn * 256 + 128 * bj + 32 * wc + 8 * (fq & 2)) = widen8(w[0][bj], w[1][bj]); }
            }
    }
};
struct SchedXaAttn {
    static constexpr bool VAR_K = false;
    const char* A; const char* B; size_t b_batch, b_head; int G, c;
    DI bool next(int i, pg8::Unit& u) const {
        const int L = i * G + c; if (L >= 512) return false;
        int pm, pn; pg8::tile_of(L, 128, 4, pm, pn); u.A = A + (size_t)pm * 256 * 2048 + pn * 512; u.B = B + (size_t)(pm >> 4) * b_batch + (size_t)pn * b_head; u.pm = pm; u.pn = pn; u.kind = 0; u.aux = 0; return true;
    }
};

struct EpiGU {
    bf16_t* H; int ldh; const float* ss; const float* rsd; int row0;
    DI void operator()(Acc& acc, const pg8::Unit& u, int wr, int wc, int fr, int fq) const {
        float rs8[2][4];
        if (ss) rstd8_from_ss(ss, u.pm * 256, wr, fr, fq, rs8); else rows8_from_tab(rsd, u.pm * 256, wr, fr, rs8);
#pragma unroll
        for (int ai = 0; ai < 2; ++ai)
#pragma unroll
            for (int m = 0; m < 4; ++m) {
                const int row = u.pm * 256 + 128 * ai + 64 * wr + 16 * m + fr;
                const float rs = rs8[ai][m]; const float c1 = -rs * 1.4426950408889634f;
                f32x4 h[2];
#pragma unroll
                for (int n = 0; n < 2; ++n)
#pragma unroll
                    for (int j = 0; j < 4; ++j) { const float ag = acc[ai][0][m][n][j]; h[n][j] = (ag * rs) * __builtin_amdgcn_rcpf(1.f + __builtin_amdgcn_exp2f(ag * c1)) * (acc[ai][1][m][n][j] * rs); }
                *(GAS u32x4*)(H + (size_t)(row - row0) * ldh + u.pn * 128 + 32 * wc + 8 * fq) = pack8(h[0], h[1]);
            }
    }
};
struct EpiSsdIn {
    bf16_t* ZX; float* DT; const float* ss; bf16_t* HALO;
    DI void operator()(Acc& acc, const pg8::Unit& u, int wr, int wc, int fr, int fq) const {
        float rs8[2][4];
        rstd8_from_ss(ss, u.pm * 256, wr, fr, fq, rs8);
#pragma unroll
        for (int ai = 0; ai < 2; ++ai)
#pragma unroll
            for (int m = 0; m < 4; ++m) {
                const int row = u.pm * 256 + 128 * ai + 64 * wr + 16 * m + fr;
                const float rs = rs8[ai][m];
                {
#pragma unroll
                    for (int bj = 0; bj < 2; ++bj) { const u32x4 pk = pack8(acc[ai][bj][m][0] * rs, acc[ai][bj][m][1] * rs);
                        *(GAS u32x4*)(ZX + zx_off(row, u.pn * 256 + 128 * bj + 32 * wc + 8 * fq)) = pk;
                        if (u.pn >= 8 && (row & 127) >= 125) *(GAS u32x4*)(HALO + ((size_t)(row >> 7) * 3 + ((row & 127) - 125)) * SSD_XBC + (u.pn - 8) * 256 + 128 * bj + 32 * wc + 8 * fq) = pk; }
                }
            }
    }
};
struct EpiBf16Out {
    bf16_t* O; int ldo; float sc;
    DI void operator()(Acc& acc, const pg8::Unit& u, int wr, int wc, int fr, int fq) const {
#pragma unroll
        for (int ai = 0; ai < 2; ++ai)
#pragma unroll
            for (int m = 0; m < 4; ++m) { const int row = u.pm * 256 + 128 * ai + 64 * wr + 16 * m + fr;
#pragma unroll
                for (int bj = 0; bj < 2; ++bj) *(GAS u32x4*)(O + (size_t)row * ldo + u.pn * 256 + 128 * bj + 32 * wc + 8 * fq) = pack8(acc[ai][bj][m][0] * sc, acc[ai][bj][m][1] * sc); }
    }
};
template <size_t A_BLK, size_t W_EXP, size_t W_TILE, int NN> struct SchedMoe {
    static constexpr bool VAR_K = false;
    const char* A; const char* W; const LAS int* tb; int nb, G, c;
    DI bool next(int i, pg8::Unit& u) const {
        const int L = i * G + c; if (L >= nb * NN) return false;
        int pm, pn; pg8::tile_of(L, nb, NN, pm, pn); const int e = __builtin_amdgcn_readfirstlane(tb[pm]);
        u.A = A + (size_t)pm * A_BLK; u.B = W + (size_t)e * W_EXP + (size_t)pn * W_TILE; u.pm = pm; u.pn = pn; u.kind = 0; u.aux = e; return true;
    }
};
template <size_t A_BLK, size_t W_EXP, size_t W_TILE> struct SchedMoeDn {
    static constexpr bool VAR_K = true;
    const char* A; const char* W; const LAS int* tb; int nb, G, c;
    DI int ktiles(const pg8::Unit& u, int nt) const { return u.kind ? 4 : nt; }
    DI bool next(int i, pg8::Unit& u) const {
        const int L = i * G + c; int pm, pn, s = 0, kind = 0;
        if (L < 1024) pg8::tile_of(L, 256, 4, pm, pn);
        else { const int q = L - 1024; if (q >= (nb - 256) * 28) return false; const int un = q / 7; s = q - un * 7; pm = 256 + (un >> 2); pn = un & 3; kind = 1; }
        const int e = __builtin_amdgcn_readfirstlane(tb[pm]);
        u.A = A + (size_t)pm * A_BLK + s * 512; u.B = W + (size_t)e * W_EXP + (size_t)pn * W_TILE + s * 512; u.pm = pm; u.pn = pn; u.kind = kind; u.aux = s; return true;
    }
};
struct EpiMoeDn {
    bf16_t* O; float* part; float sc;
    DI void operator()(Acc& acc, const pg8::Unit& u, int wr, int wc, int fr, int fq) const {
        if (u.kind == 0) {
            asm volatile("; full-K unit" ::: "memory");
#pragma unroll
            for (int ai = 0; ai < 2; ++ai)
#pragma unroll
                for (int m = 0; m < 4; ++m) { const int row = u.pm * 256 + 128 * ai + 64 * wr + 16 * m + fr;
#pragma unroll
                    for (int bj = 0; bj < 2; ++bj) *(GAS u32x4*)(O + (size_t)row * DM + u.pn * 256 + 128 * bj + 32 * wc + 8 * fq) = pack8(acc[ai][bj][m][0] * sc, acc[ai][bj][m][1] * sc); }
        } else {
            asm volatile("; split-K unit" ::: "memory");
            float* pb = part + (size_t)u.aux * (2048 * 1024) + (size_t)(u.pm - 256) * (256 * 1024) + u.pn * 256;
#pragma unroll
            for (int ai = 0; ai < 2; ++ai)
#pragma unroll
                for (int m = 0; m < 4; ++m) { const int row = 128 * ai + 64 * wr + 16 * m + fr;
#pragma unroll
                    for (int bj = 0; bj < 2; ++bj) { GAS f32x4* d = (GAS f32x4*)(pb + (size_t)row * DM + 128 * bj + 32 * wc + 8 * fq); d[0] = acc[ai][bj][m][0] * sc; d[1] = acc[ai][bj][m][1] * sc; } }
        }
    }
};

struct EpiGU8 {
    unsigned char* H; int ldh; const float* ss; const float* rsd;
    DI void operator()(Acc& acc, const pg8::Unit& u, int wr, int wc, int fr, int fq) const {
        float rs8[2][4];
        if (ss) rstd8_from_ss(ss, u.pm * 256, wr, fr, fq, rs8); else rows8_from_tab(rsd, u.pm * 256, wr, fr, rs8);
#pragma unroll
        for (int ai = 0; ai < 2; ++ai)
#pragma unroll
            for (int mp = 0; mp < 2; ++mp) {
                u32x2 w[2];
#pragma unroll
                for (int mm = 0; mm < 2; ++mm) { const int m = 2 * mp + mm;
                    const float rs = rs8[ai][m] * (1.f / MOE_WSCALE), c1 = -rs * 1.4426950408889634f, c2 = rs * MOE_HSCALE;
                    f32x4 h[2];
#pragma unroll
                    for (int n = 0; n < 2; ++n)
#pragma unroll
                        for (int j = 0; j < 4; ++j) { const float ag = acc[ai][0][m][n][j]; h[n][j] = (ag * rs) * __builtin_amdgcn_rcpf(1.f + __builtin_amdgcn_exp2f(ag * c1)) * (acc[ai][1][m][n][j] * c2); }
                    w[mm].x = pk4_fp8(h[0][0], h[0][1], h[0][2], h[0][3]); w[mm].y = pk4_fp8(h[1][0], h[1][1], h[1][2], h[1][3]); }
                const int row = u.pm * 256 + 128 * ai + 64 * wr + 16 * (2 * mp + (fq & 1)) + fr;
                *(GAS u32x4*)(H + (size_t)row * ldh + u.pn * 128 + 32 * wc + 8 * (fq & 2)) = widen8(w[0], w[1]);
            }
    }
};
DI void moe_router(const Params& P, const Ctx& C0) {
    PHASE_CTX(C0);
    unsigned char* rt = P.ws + WS_ROUTE;
    int* tok_e = (int*)(rt + RT_E); float* tok_g = (float*)(rt + RT_G); int* tok_rank = (int*)(rt + RT_RANK); float* tok_rs = (float*)(rt + RT_RS); int* wg_cnt = (int*)(rt + RT_CNT);
    const float* LP = (const float*)(P.ws + WS_LP); const float* SSp = (const float*)(P.ws + WS_SS);
    LAS int* pe = (LAS int*)(C.lds + 32768);
    const int tpw = NTOK / C.G;
    for (int lt0 = C.wave * 2; lt0 < tpw; lt0 += NWAVES * 2) {
        const int lt = lt0 + (C.lane >> 5), tok = blockIdx.x * tpw + lt, p = C.lane & 31;
        const f32x4 a = *(const GAS f32x4*)(LP + ((size_t)tok * 32 + p) * 8), b = *(const GAS f32x4*)(LP + ((size_t)tok * 32 + p) * 8 + 4);
        float sq = SSp[(size_t)tok * 16 + (p & 15)]; sq = p < 16 ? sq : 0.f; sq = dpp_row_sum(sq); sq += shx(sq, 16);
        float l8[8];
#pragma unroll
        for (int e = 0; e < 4; ++e) { l8[e] = dpp_row_sum(a[e]); l8[e] += shx(l8[e], 16); l8[4 + e] = dpp_row_sum(b[e]); l8[4 + e] += shx(l8[4 + e], 16); }
        const float rs = __builtin_amdgcn_rsqf(sq * (1.f / 1024.f) + EPS);
        int e0 = 0; float b0 = l8[0];
#pragma unroll
        for (int e = 1; e < 8; ++e) if (l8[e] > b0) { b0 = l8[e]; e0 = e; }
        int e1 = -1; float b1 = -INFINITY;
#pragma unroll
        for (int e = 0; e < 8; ++e) if (e != e0 && l8[e] > b1) { b1 = l8[e]; e1 = e; }
        const float g1 = 1.f / (1.f + __expf((b0 - b1) * rs)), g0 = 1.f - g1;
        if (p == 0) { tok_e[tok * 2] = e0; tok_e[tok * 2 + 1] = e1; tok_g[tok * 2] = g0; tok_g[tok * 2 + 1] = g1; tok_rs[tok] = rs; pe[lt * 2] = e0; pe[lt * 2 + 1] = e1; }
    }
    __syncthreads();
    const int npair = 2 * tpw;
    for (int t = C.tid; t < npair; t += NTHR) { const int e = pe[t]; int r = 0; for (int u = 0; u < t; ++u) r += (pe[u] == e); tok_rank[blockIdx.x * npair + t] = r; }
    if (C.tid < 8) { int cnt = 0; for (int u = 0; u < npair; ++u) cnt += (pe[u] == C.tid); wg_cnt[blockIdx.x * 8 + C.tid] = cnt; }
}
DI void moe_scatter(const Params& P, const Ctx& C0) {
    PHASE_CTX(C0);
    unsigned char* rt = P.ws + WS_ROUTE;
    const int* tok_e = (const int*)(rt + RT_E); const int* tok_rank = (const int*)(rt + RT_RANK); const float* tok_rs = (const float*)(rt + RT_RS); const int* wg_cnt = (const int*)(rt + RT_CNT);
    int* tok_dest = (int*)(rt + RT_DEST); int* blke = (int*)(rt + RT_BLKE); float* rsd = (float*)(rt + RT_RSD);
    LAS int* sh = (LAS int*)C.lds;
    __syncthreads();
    for (int i = C.tid; i < C.G * 8; i += NTHR) sh[64 + i] = wg_cnt[i];
    __syncthreads();
    if (C.tid < 8) { int tot = 0, mine = 0; for (int w = 0; w < C.G; ++w) { const int c = sh[64 + w * 8 + C.tid]; if (w < (int)blockIdx.x) mine += c; tot += c; } sh[C.tid] = mine; sh[32 + C.tid] = (tot + 255) & ~255; }
    __syncthreads();
    if (C.tid == 0) { int acc = 0; for (int e = 0; e < 8; ++e) { sh[8 + e] = acc; acc += sh[32 + e]; sh[16 + e] = acc; } }
    __syncthreads();
    if (blockIdx.x == 0) { for (int blk = C.tid; blk < 264; blk += NTHR) { int e = 0; for (int k = 0; k < 8; ++k) e += (blk * 256 >= sh[16 + k]); blke[blk] = e < 7 ? e : 7; } if (C.tid == 0) blke[264] = sh[16 + 7] >> 8; }
    const int tpw = NTOK / C.G, npair = 2 * tpw;
    const unsigned char* hA = P.ws + WS_HNA3; unsigned char* X = P.ws + WS_XBUF8;
    for (int t0 = C.wave * 8; t0 < npair; t0 += NWAVES * 8) {
        u32x4 rowv[8]; int dst[8];
#pragma unroll
        for (int k = 0; k < 8; ++k) { const int pidx = blockIdx.x * npair + t0 + k, tok = pidx >> 1; const int e = tok_e[pidx]; dst[k] = sh[8 + e] + sh[e] + tok_rank[pidx];
            rowv[k] = ((const GAS u32x4*)(hA + (size_t)tok * DM))[C.lane]; }
#pragma unroll
        for (int k = 0; k < 8; ++k) { const int pidx = blockIdx.x * npair + t0 + k, tok = pidx >> 1;
            ((GAS u32x4*)(X + (size_t)dst[k] * DM))[C.lane] = rowv[k];
            if (C.lane == 0) { tok_dest[pidx] = dst[k]; rsd[dst[k]] = tok_rs[tok]; } }
    }
}
DI void moe_combine(const Params& P, const Ctx& C0) {
    PHASE_CTX(C0);
    unsigned char* rt = P.ws + WS_ROUTE; const float* tok_g = (const float*)(rt + RT_G); const int* tok_dest = (const int*)(rt + RT_DEST);
    const bf16_t* Yb = (const bf16_t*)(P.ws + WS_YBUF); const float* PART = (const float*)(P.ws + WS_XBUF8);
    for (int tok0 = C.gw; tok0 < NTOK; tok0 += 2 * C.NGW) {
        u32x2 hv[2][4], ya[2][4], yb[2][4]; float g0[2], g1[2];
#pragma unroll
        for (int t = 0; t < 2; ++t) { const int tok = tok0 + t * C.NGW; const int d0 = __builtin_amdgcn_readfirstlane(tok_dest[tok * 2]), d1 = __builtin_amdgcn_readfirstlane(tok_dest[tok * 2 + 1]); g0[t] = tok_g[tok * 2]; g1[t] = tok_g[tok * 2 + 1];
            const GAS unsigned char* o = (const GAS unsigned char*)P.out + (size_t)tok * 4096; const GAS u32x2* y0 = (const GAS u32x2*)(Yb + (size_t)d0 * DM); const GAS u32x2* y1 = (const GAS u32x2*)(Yb + (size_t)d1 * DM);
#pragma unroll
            for (int j = 0; j < 4; ++j) { const int i = 64 * j + C.lane; hv[t][j] = *(const GAS u32x2*)(o + 1024 * j + 8 * C.lane); ya[t][j] = y0[i]; yb[t][j] = y1[i]; }
            if (d0 >= 65536) { asm volatile("; split-K row" ::: "memory");
#pragma unroll
                for (int j = 0; j < 4; ++j) { f32x4 a = {0.f, 0.f, 0.f, 0.f}; for (int s = 0; s < 7; ++s) a += ((const GAS f32x4*)(PART + ((size_t)s * 2048 + (d0 - 65536)) * DM))[64 * j + C.lane]; u32x2 w; w.x = pk2(a[0], a[1]); w.y = pk2(a[2], a[3]); ya[t][j] = w; } }
            if (d1 >= 65536) { asm volatile("; split-K row" ::: "memory");
#pragma unroll
                for (int j = 0; j < 4; ++j) { f32x4 a = {0.f, 0.f, 0.f, 0.f}; for (int s = 0; s < 7; ++s) a += ((const GAS f32x4*)(PART + ((size_t)s * 2048 + (d1 - 65536)) * DM))[64 * j + C.lane]; u32x2 w; w.x = pk2(a[0], a[1]); w.y = pk2(a[2], a[3]); yb[t][j] = w; } } }
#pragma unroll
        for (int t = 0; t < 2; ++t) { const int tok = tok0 + t * C.NGW; GAS f32x4* o = (GAS f32x4*)(P.out + (size_t)tok * DM);
#pragma unroll
            for (int j = 0; j < 4; ++j) { const u32x2 hb = hv[t][j]; f32x4 v = {bflo(hb.x), bfhi(hb.x), bflo(hb.y), bfhi(hb.y)}; const u32x2 a = ya[t][j], b = yb[t][j];
                v[0] += g0[t] * bflo(a.x) + g1[t] * bflo(b.x); v[1] += g0[t] * bfhi(a.x) + g1[t] * bfhi(b.x); v[2] += g0[t] * bflo(a.y) + g1[t] * bflo(b.y); v[3] += g0[t] * bfhi(a.y) + g1[t] * bfhi(b.y); o[64 * j + C.lane] = v; } }
    }
}
typedef __bf16 bf16x2_t __attribute__((ext_vector_type(2)));
DI unsigned cvtpk(float lo, float hi) { f32x2 v = {lo, hi}; bf16x2_t b = __builtin_convertvector(v, bf16x2_t); return __builtin_bit_cast(unsigned, b); }
DI void moba_mfma(const Params& P, const Ctx& C0) {
    PHASE_CTX(C0);
    const int lane = C.lane, w = C.wave, r = lane & 31, hh = lane >> 5;
    const bf16_t* Qg = (const bf16_t*)(P.ws + WS_QKU); const bf16_t* Kg = Qg + (size_t)NTOK * 512; const bf16_t* VTg = (const bf16_t*)(P.ws + WS_VT);
    const float* kmp = (const float*)(P.ws + WS_KMP); bf16_t* AP = (bf16_t*)(P.ws + WS_AP);
    LAS unsigned char* KB = C.lds; LAS unsigned char* VB = C.lds + 65536; LAS float* KM = (LAS float*)(C.lds + XS_OFF);
    const int pr = (r & 16) + ((r >> 2) & 1) * 8 + ((r >> 3) & 1) * 4 + (r & 3);
    for (int it = blockIdx.x; it < 512; it += C.G) {
        const int xcd = it & 7, slot = it >> 3, pp = slot & 7, bh = xcd * 8 + (slot >> 3), b = bh >> 3, h = bh & 7;
        for (int half = 0; half < 2; ++half) {
            const int own = half == 0 ? pp : 15 - pp;
            const int row0 = b * SEQ + own * 256;
            for (int i = C.tid; i < 16 * 64; i += NTHR) { const int j = i >> 6, d = i & 63; float v = 0.f;
                if (j < own) { const float* k0 = kmp + (size_t)((b * 16 + j) * 2) * 512 + h * 64 + d; v = k0[0] + k0[512]; } KM[i] = v; }
            LDS_WAIT(); __builtin_amdgcn_s_barrier(); asm volatile("" ::: "memory");
#define MOBA_DMA(j) do { const int bf_ = (j) & 1; _Pragma("unroll") for (int q_ = 0; q_ < 4; ++q_) { const int q = 4 * w + q_; \
                { const int row = 8 * q + (lane >> 3), c = (lane & 7) ^ ((row >> 1) & 7); \
                  __builtin_amdgcn_global_load_lds((const unsigned*)(Kg + (size_t)(b * SEQ + (j) * 256 + row) * 512 + h * 64 + c * 8), (LAS unsigned*)(KB + bf_ * 32768 + q * 1024), 16, 0, 0); } \
                { const int row = 2 * q + (lane >> 5), cq = (lane & 31) ^ (row & 15); \
                  __builtin_amdgcn_global_load_lds((const unsigned*)(VTg + (size_t)(h * 64 + row) * NTOK + b * SEQ + (j) * 256 + cq * 8), (LAS unsigned*)(VB + bf_ * 32768 + q * 1024), 16, 0, 0); } } } while (0)
            MOBA_DMA(0);
            bf16x8 qf[4];
#pragma unroll
            for (int s = 0; s < 4; ++s) qf[s] = *(const GAS bf16x8*)(Qg + (size_t)(row0 + 32 * w + r) * 512 + h * 64 + 16 * s + 8 * hh);
            unsigned sel = 0u;
            if (own <= 3) sel = (1u << own) - 1u;
            else {
                float g[15];
#pragma unroll
                for (int j = 0; j < 15; ++j) { float a = 0.f;
                    if (j < own) {
#pragma unroll
                        for (int s = 0; s < 4; ++s) { const f32x4 k0 = *(const LAS f32x4*)(KM + j * 64 + 16 * s + 8 * hh), k1 = *(const LAS f32x4*)(KM + j * 64 + 16 * s + 8 * hh + 4);
#pragma unroll
                            for (int t = 0; t < 4; ++t) { a += bf2f((unsigned short)qf[s][t]) * k0[t]; a += bf2f((unsigned short)qf[s][4 + t]) * k1[t]; } }
                        a += shx(a, 32); }
                    g[j] = a; }
#pragma unroll
                for (int pass = 0; pass < 3; ++pass) { float best = -INFINITY; int bi = 0;
#pragma unroll
                    for (int j = 0; j < 15; ++j) { const bool c = (j < own) && !((sel >> j) & 1u) && (g[j] > best); best = c ? g[j] : best; bi = c ? j : bi; }
                    sel |= 1u << bi; }
            }
            unsigned kofs[4], vofs[4];
#pragma unroll
            for (int s = 0; s < 4; ++s) kofs[s] = pr * 128 + (((2 * s + hh) ^ ((pr >> 1) & 7)) << 4);
#pragma unroll
            for (int q = 0; q < 4; ++q) vofs[q] = r * 512 + (((2 * q + hh) ^ (r & 7)) << 4);
            const unsigned vk0 = (r & 8) << 4, vk1 = 128u - vk0;
            f32x16 O0, O1;
#pragma unroll
            for (int i = 0; i < 16; ++i) { O0[i] = 0.f; O1[i] = 0.f; }
            float l = 0.f;
            const int qi = 32 * w + r;
            for (int j = 0; j <= own; ++j) {
                VM_WAIT(); __builtin_amdgcn_s_barrier(); asm volatile("" ::: "memory");
                if (j < own) MOBA_DMA(j + 1);
                const float bias = (j == own) ? 0.f : (((sel >> j) & 1u) ? 0.f : -INFINITY);
                const LAS unsigned char* kb = KB + (j & 1) * 32768; const LAS unsigned char* vb = VB + (j & 1) * 32768;
#pragma unroll 1
                for (int kt = 0; kt < 4; ++kt) {
                    if (j == own && 64 * kt > 32 * w + 31) break;
                    const bool diag = (j == own) && (64 * kt + 63 > 32 * w);
                    u32x4 pa[2][2];
#pragma unroll
                    for (int mt = 0; mt < 2; ++mt) {
                        f32x16 X;
#pragma unroll
                        for (int i = 0; i < 16; ++i) X[i] = bias;
#pragma unroll
                        for (int s = 0; s < 4; ++s) { const bf16x8 kf = *(const LAS bf16x8*)(kb + (64 * kt + 32 * mt) * 128 + kofs[s]);
                            X = __builtin_amdgcn_mfma_f32_32x32x16_bf16(kf, qf[s], X, 0, 0, 0); }
                        if (diag) {
                            asm volatile("; diagonal tile" ::: "memory");
#pragma unroll
                            for (int i = 0; i < 16; ++i) { const int ki = 64 * kt + 32 * mt + 16 * (i >> 3) + 8 * hh + 4 * ((i >> 2) & 1) + (i & 3); X[i] = (ki <= qi) ? X[i] : -INFINITY; }
                        }
#pragma unroll
                        for (int i = 0; i < 16; ++i) { const float p = __builtin_amdgcn_exp2f(X[i]); X[i] = p; l += p; }
#pragma unroll
                        for (int s2 = 0; s2 < 2; ++s2) { pa[mt][s2].x = cvtpk(X[8 * s2], X[8 * s2 + 1]); pa[mt][s2].y = cvtpk(X[8 * s2 + 2], X[8 * s2 + 3]); pa[mt][s2].z = cvtpk(X[8 * s2 + 4], X[8 * s2 + 5]); pa[mt][s2].w = cvtpk(X[8 * s2 + 6], X[8 * s2 + 7]); }
                    }
#pragma unroll
                    for (int mt = 0; mt < 2; ++mt)
#pragma unroll
                        for (int s2 = 0; s2 < 2; ++s2) { const unsigned vo = vofs[2 * mt + s2] + ((kt & 1) ? vk1 : vk0) + 256 * (kt >> 1);
                            const bf16x8 v0 = *(const LAS bf16x8*)(vb + vo), v1 = *(const LAS bf16x8*)(vb + 32 * 512 + vo);
                            const bf16x8 pf = __builtin_bit_cast(bf16x8, pa[mt][s2]);
                            O0 = __builtin_amdgcn_mfma_f32_32x32x16_bf16(pf, v0, O0, 0, 0, 0); O1 = __builtin_amdgcn_mfma_f32_32x32x16_bf16(pf, v1, O1, 0, 0, 0); }
                }
            }
            l += shx(l, 32);
            const float inv = 1.f / l;
#pragma unroll
            for (int i = 0; i < 16; ++i) { const int q = (i & 3) + 8 * (i >> 2) + 4 * hh; const float iv = shl_from(inv, q);
                bf16_t* o = AP + (size_t)(row0 + 32 * w + q) * DM + h * 64 + r;
                o[0] = (bf16_t)f2bf(O0[i] * iv); o[32] = (bf16_t)f2bf(O1[i] * iv); }
        }
    }
    VM_WAIT(); __builtin_amdgcn_s_barrier();
#undef MOBA_DMA
}
DI void pool_mfma(const Params& P, const Ctx& C0) {
    PHASE_CTX(C0);
    const int lane = C.lane, w = C.wave, r = lane & 31, hh = lane >> 5, tid = C.tid;
    const bf16_t* U = (const bf16_t*)(P.ws + WS_QKU) + (size_t)2 * NTOK * 512; bf16_t* AP = (bf16_t*)(P.ws + WS_AP);
    const bf16_t* WP = (const bf16_t*)(P.ws + WS_WPOOL);
    LAS unsigned char* UT = C.lds;
    for (int unit = blockIdx.x; unit < 512; unit += C.G) {
        const int pm = unit >> 2, g = unit < 256 ? (unit & 3) : 3 - (unit & 3), win = 2 << g, row0 = pm * 256;
        __builtin_amdgcn_s_barrier(); asm volatile("" ::: "memory");
        {
            u32x4 v[9];
#pragma unroll
            for (int k = 0; k < 9; ++k) { const int i = tid + NTHR * k, ir = i >> 4, ch = i & 15, grow = row0 - 16 + ir;
                v[k] = (u32x4){0u, 0u, 0u, 0u}; if (i < 272 * 16 && grow >= 0) v[k] = *(const GAS u32x4*)(U + (size_t)grow * 512 + g * 128 + ch * 8); }
#pragma unroll
            for (int k = 0; k < 9; ++k) { const int i = tid + NTHR * k, ir = i >> 4, ch = i & 15;
                if (i < 272 * 16) *(LAS u32x4*)(UT + ir * 256 + ((ch ^ (ir & 15)) << 4)) = v[k]; }
        }
        LDS_WAIT(); __builtin_amdgcn_s_barrier(); asm volatile("" ::: "memory");
        const int lrow = 32 * w + r, ir0 = lrow + 16, s = (row0 + lrow) & (SEQ - 1);
        const int cnt = (s + 1 < win) ? s + 1 : win; const float icnt = 1.f / (float)cnt;
        f32x16 acc[4];
#pragma unroll
        for (int nt = 0; nt < 4; ++nt)
#pragma unroll
            for (int i = 0; i < 16; ++i) acc[nt][i] = 0.f;
#pragma unroll 1
        for (int ks = 0; ks < 8; ++ks) {
            const int ch = 2 * ks + hh;
            float sum[8];
#pragma unroll
            for (int j = 0; j < 8; ++j) sum[j] = 0.f;
            u32x4 self = (u32x4){0u, 0u, 0u, 0u};
            for (int t = 0; t < win; ++t) {
                const int ir = ir0 - t; const u32x4 v = *(const LAS u32x4*)(UT + ir * 256 + ((ch ^ (ir & 15)) << 4));
                if (t == 0) self = v;
                const float m = t < cnt ? 1.f : 0.f;
                sum[0] += m * bflo(v.x); sum[1] += m * bfhi(v.x); sum[2] += m * bflo(v.y); sum[3] += m * bfhi(v.y); sum[4] += m * bflo(v.z); sum[5] += m * bfhi(v.z); sum[6] += m * bflo(v.w); sum[7] += m * bfhi(v.w);
            }
            u32x4 af;
            af.x = cvtpk(sum[0] * icnt - bflo(self.x), sum[1] * icnt - bfhi(self.x)); af.y = cvtpk(sum[2] * icnt - bflo(self.y), sum[3] * icnt - bfhi(self.y));
            af.z = cvtpk(sum[4] * icnt - bflo(self.z), sum[5] * icnt - bfhi(self.z)); af.w = cvtpk(sum[6] * icnt - bflo(self.w), sum[7] * icnt - bfhi(self.w));
            const bf16x8 a8 = __builtin_bit_cast(bf16x8, af);
#pragma unroll
            for (int nt = 0; nt < 4; ++nt) { const bf16x8 b8 = *(const GAS bf16x8*)(WP + (size_t)g * 16384 + (32 * nt + r) * 128 + 16 * ks + 8 * hh);
                acc[nt] = __builtin_amdgcn_mfma_f32_32x32x16_bf16(a8, b8, acc[nt], 0, 0, 0); }
        }
        LAS unsigned char* OT = C.lds + 69632 + w * 8192;
#pragma unroll
        for (int nt = 0; nt < 4; ++nt) { const float sc = P.pool_scale[g * 128 + 32 * nt + r];
#pragma unroll
            for (int i = 0; i < 16; ++i) { const int q = (i & 3) + 8 * (i >> 2) + 4 * hh;
                *(LAS unsigned short*)(OT + q * 256 + (32 * nt + r) * 2) = (unsigned short)f2bf(acc[nt][i] * sc); } }
        LDS_WAIT(); asm volatile("" ::: "memory");
#pragma unroll
        for (int k = 0; k < 8; ++k) { const int pc = lane + 64 * k, orow = pc >> 4, och = pc & 15;
            *(GAS u32x4*)(AP + (size_t)(row0 + 32 * w + orow) * DM + 512 + g * 128 + och * 8) = *(const LAS u32x4*)(OT + orow * 256 + och * 16); }
    }
    __builtin_amdgcn_s_barrier();
}
typedef short v4i16_t __attribute__((ext_vector_type(4)));
DI unsigned off_b(unsigned row, unsigned ch) { return 256u * row + 16u * (ch ^ (((row & 3u) << 2) | ((row >> 2) & 3u))); }
DI void ssd_conv_prepass(const Params& P, const Ctx& C0) {
    PHASE_CTX(C0);
    bf16_t* ZX = (bf16_t*)(P.ws + WS_ZX); const bf16_t* HALO = (const bf16_t*)(P.ws + WS_HALO);
    const bf16_t* hnA = (const bf16_t*)(P.ws + WS_HNA); const bf16_t* Wdt = (const bf16_t*)(P.ws + WS_WSMALL) + WO_SIN + (size_t)5120 * 1024;
    const float* ss = (const float*)(P.ws + WS_SS); float* DTo = (float*)(P.ws + WS_DT);
    LAS float* red = (LAS float*)C.lds;
    LAS float* rsl = (LAS float*)(C.lds + 16384);
    for (int chunk = blockIdx.x; chunk < NTOK / 128; chunk += C.G) {
        const int c = chunk & 31;
        {
            const int lane = C.lane, w = C.wave, r = lane & 31, hh = lane >> 5, rt = w & 3, kh = w >> 2;
            __builtin_amdgcn_s_barrier();
            if (C.tid < 128) { const float* sp = ss + (size_t)(chunk * 128 + C.tid) * 16; float a = 0.f;
#pragma unroll
                for (int q = 0; q < 4; ++q) { const f32x4 t = *(const GAS f32x4*)(sp + 4 * q); a += (t[0] + t[1]) + (t[2] + t[3]); }
                rsl[C.tid] = __builtin_amdgcn_rsqf(a * (1.f / 1024.f) + EPS); }
            f32x16 acc;
#pragma unroll
            for (int i = 0; i < 16; ++i) acc[i] = 0.f;
            const bf16_t* ap = hnA + (size_t)(chunk * 128 + 32 * rt + r) * DM + 512 * kh + 8 * hh; const bf16_t* bp = Wdt + (size_t)r * 1024 + 512 * kh + 8 * hh;
#pragma unroll 8
            for (int ks = 0; ks < 32; ++ks) acc = __builtin_amdgcn_mfma_f32_32x32x16_bf16(*(const GAS bf16x8*)(ap + 16 * ks), *(const GAS bf16x8*)(bp + 16 * ks), acc, 0, 0, 0);
            if (kh == 1) {
#pragma unroll
                for (int i = 0; i < 16; ++i) red[(rt * 16 + i) * 64 + lane] = acc[i]; }
            LDS_WAIT(); __builtin_amdgcn_s_barrier(); asm volatile("" ::: "memory");
            if (kh == 0) {
#pragma unroll
                for (int i = 0; i < 16; ++i) { const int row = 32 * rt + (i & 3) + 8 * (i >> 2) + 4 * hh;
                    DTo[(size_t)(chunk * 128 + row) * 32 + r] = (acc[i] + red[(rt * 16 + i) * 64 + lane]) * rsl[row]; } }
        }
#pragma unroll 1
        for (int k = 0; k < 3; ++k) {
            const int ch = 2 * (C.tid + 512 * k);
            f32x2 cw[4];
#pragma unroll
            for (int i = 0; i < 4; ++i) cw[i] = *(const GAS f32x2*)(P.conv_w + i * SSD_XBC + ch);
            const f32x2 cb = *(const GAS f32x2*)(P.conv_b + ch);
            unsigned r0 = 0u, r1 = 0u, r2 = 0u;
            if (c > 0) { const bf16_t* hp = HALO + (size_t)(chunk - 1) * 3 * SSD_XBC + ch; r0 = *(const GAS unsigned*)hp; r1 = *(const GAS unsigned*)(hp + SSD_XBC); r2 = *(const GAS unsigned*)(hp + 2 * SSD_XBC); }
            GAS unsigned* col = (GAS unsigned*)(ZX + zx_off(chunk * 128, 2048 + ch));
#pragma unroll 1
            for (int t0 = 0; t0 < 128; t0 += 32) {
                unsigned v[32];
#pragma unroll
                for (int j = 0; j < 32; ++j) v[j] = col[(size_t)(t0 + j) * 128];
#pragma unroll
                for (int j = 0; j < 32; ++j) {
                    const float a0 = cb.x + bflo(r0) * cw[0].x + bflo(r1) * cw[1].x + bflo(r2) * cw[2].x + bflo(v[j]) * cw[3].x;
                    const float a1 = cb.y + bfhi(r0) * cw[0].y + bfhi(r1) * cw[1].y + bfhi(r2) * cw[2].y + bfhi(v[j]) * cw[3].y;
                    col[(size_t)(t0 + j) * 128] = pk2(silu_f(a0), silu_f(a1));
                    r0 = r1; r1 = r2; r2 = v[j];
                }
            }
        }
    }
}
DI void ssd_chunked2(const Params& P, const Ctx& C0, bf16_t* Yout, float* YSSout) {
    PHASE_CTX(C0);
    const int w = C.wave;
    const bf16_t* ZX = (const bf16_t*)(P.ws + WS_ZX); const float* DT = (const float*)(P.ws + WS_DT); bf16_t* Y = Yout; float* YSS = YSSout;
    LAS unsigned char* CI = C.lds; LAS unsigned char* BI = C.lds + 32768; LAS unsigned char* XI = C.lds + 65536; LAS unsigned char* SB = C.lds + 98304;
    LAS float* ACU = (LAS float*)(C.lds + XS_OFF); LAS float* DTV = ACU + 128; LAS float* FWV = ACU + 256; LAS float* E2 = ACU + 384 + 128 * w; LAS float* SQT = ACU + 1408; LAS unsigned char* YT = C.lds + 114688; LAS unsigned char* GT = C.lds + GT_OFF;
    const int tt = w < 4 ? (w >> 1) : 3 - ((w - 4) >> 1), pt = w & 1, nt = w >> 1;
    for (int unit = blockIdx.x; unit < NBATCH * SSD_H; unit += C.G) {
        const int bgp = (unit & 7) + 8 * (unit >> 6), b = bgp >> 2, g = bgp & 3, hd = 8 * g + ((unit >> 3) & 7);
        const float a = -__expf(P.a_log[hd]), dbias = P.dt_bias[hd], dskip = P.ssd_d[hd];
        u32x4 pf[12];
        unsigned pfo[12], lwo[12];
        { int tl = TID_FROM_WAVE(w); asm volatile("" : "+v"(tl));
#pragma unroll
          for (int k = 0; k < 12; ++k) { const int j_ = tl + 512 * (k & 3); const int row_ = k < 8 ? (j_ >> 4) : ((tl + 512 * (k & 1)) >> 3), ch_ = k < 8 ? (j_ & 15) : (tl & 7);
              const int col_ = k < 4 ? 2048 + 2560 + g * 128 + ch_ * 8 : (k < 8 ? 2048 + 2048 + g * 128 + ch_ * 8 : (k < 10 ? 2048 + hd * 64 + ch_ * 8 : hd * 64 + ch_ * 8));
              pfo[k] = (unsigned)(((col_ >> 8) * 65536 + row_ * 256 + (col_ & 255)) * 2);
              lwo[k] = (k < 4 ? 0u : (k < 8 ? 32768u : 65536u)) + off_b(row_, k < 8 ? ch_ : (k < 10 ? ch_ : 8 + ch_)); } }
#define SSD2_PREFETCH(c_) do { const GAS char* cb_ = (const GAS char*)ZX + ((size_t)((b * 16 + ((c_) >> 1)) * 20) * 65536 + (size_t)((c_) & 1) * 32768) * 2; \
            _Pragma("unroll") for (int k = 0; k < 12; ++k) pf[k] = *(const GAS u32x4*)(cb_ + pfo[k]); } while (0)
        float dtr0, dtr1;
        { SSD2_PREFETCH(0); const int lane = lane_id(); dtr0 = DT[(size_t)(b * SEQ + lane) * 32 + hd]; dtr1 = DT[(size_t)(b * SEQ + 64 + lane) * 32 + hd]; }
        f32x16 S;
#pragma unroll
        for (int i = 0; i < 16; ++i) S[i] = 0.f;
        for (int c = 0; c < 32; ++c) {
            const int t0 = c * 128;
            int tid = TID_FROM_WAVE(w); asm volatile("" : "+v"(tid));
            const int lane = tid & 63, r = lane & 31, hh = lane >> 5;
            const int pr = (r & 16) + ((r >> 2) & 1) * 8 + ((r >> 3) & 1) * 4 + (r & 3);
            float x0 = dtr0 + dbias, x1 = dtr1 + dbias;
            float dt0 = x0 > 20.f ? x0 : __logf(1.f + __expf(x0)), dt1 = x1 > 20.f ? x1 : __logf(1.f + __expf(x1));
            dt0 = fmaxf(dt0, 1e-30f); dt1 = fmaxf(dt1, 1e-30f);
            float s0 = dt0 * a, s1 = dt1 * a;
            s0 = wave_incl_scan(s0); s1 = wave_incl_scan(s1);
            s1 += lane_val(s0, 63);
            const float a_last = lane_val(s1, 63);
            __builtin_amdgcn_s_barrier(); asm volatile("" ::: "memory");
            ACU[lane] = s0; ACU[64 + lane] = s1; DTV[lane] = dt0; DTV[64 + lane] = dt1; FWV[lane] = __expf(a_last - s0); FWV[64 + lane] = __expf(a_last - s1);
            { const float aref = tt > 0 ? lane_val(tt == 3 ? s1 : s0, tt == 2 ? 63 : 31) : 0.f;
              E2[lane] = __expf(aref - s0); E2[64 + lane] = __expf(aref - s1); }
            LDS_WAIT(); asm volatile("" ::: "memory");
#pragma unroll
            for (int k = 0; k < 8; ++k) *(LAS u32x4*)(C.lds + lwo[k]) = pf[k];
#pragma unroll
            for (int k = 8; k < 10; ++k) { const int row = (tid + 512 * (k - 8)) >> 3; const float d = DTV[row]; const u32x4 v = pf[k]; u32x4 o;
                o.x = pk2(bflo(v.x) * d, bfhi(v.x) * d); o.y = pk2(bflo(v.y) * d, bfhi(v.y) * d); o.z = pk2(bflo(v.z) * d, bfhi(v.z) * d); o.w = pk2(bflo(v.w) * d, bfhi(v.w) * d);
                *(LAS u32x4*)(C.lds + lwo[k]) = o; }
#pragma unroll
            for (int k = 10; k < 12; ++k) *(LAS u32x4*)(C.lds + lwo[k]) = pf[k];
            if (c < 31) { SSD2_PREFETCH(c + 1); dtr0 = DT[(size_t)(b * SEQ + t0 + 128 + lane) * 32 + hd]; dtr1 = DT[(size_t)(b * SEQ + t0 + 192 + lane) * 32 + hd]; }
            LDS_WAIT(); __builtin_amdgcn_s_barrier(); asm volatile("" ::: "memory");
            f32x16 Yv;
#pragma unroll
            for (int i = 0; i < 16; ++i) Yv[i] = 0.f;
            const int crow_c = 32 * tt + r, prow = 32 * pt + r;
            bf16x8 cfr[8];
#pragma unroll
            for (int ks = 0; ks < 8; ++ks) cfr[ks] = *(const LAS bf16x8*)(CI + off_b(crow_c, 2 * ks + hh));
            unsigned bof[8];
#pragma unroll
            for (int ks = 0; ks < 8; ++ks) bof[ks] = off_b(pr, 2 * ks + hh);
            const unsigned trh = lane >> 5, trblk = (lane >> 4) & 1, trq = (lane & 15) >> 2, trp = lane & 3;
            const unsigned xtr0 = off_b(8 * trh + trq, 4 * pt + 2 * trblk + (trp >> 1)) + 8 * (trp & 1), xtr1 = off_b(8 * trh + 4 + trq, 4 * pt + 2 * trblk + (trp >> 1)) + 8 * (trp & 1);
            const unsigned btr0 = off_b(8 * trh + trq, 4 * nt + 2 * trblk + (trp >> 1)) + 8 * (trp & 1), btr1 = off_b(8 * trh + 4 + trq, 4 * nt + 2 * trblk + (trp >> 1)) + 8 * (trp & 1);
#define SSD2_TR(img, a0, a1, kstep) __builtin_shufflevector(__builtin_amdgcn_ds_read_tr16_b64_v4i16((LAS v4i16_t*)((img) + (a0) + 4096 * (kstep))), __builtin_amdgcn_ds_read_tr16_b64_v4i16((LAS v4i16_t*)((img) + (a1) + 4096 * (kstep))), 0, 1, 2, 3, 4, 5, 6, 7)
            if (c > 0) {
#pragma unroll
                for (int ks = 0; ks < 8; ++ks) { const bf16x8 bfv = *(const LAS bf16x8*)(SB + off_b(prow, 2 * ks + hh));
                    Yv = __builtin_amdgcn_mfma_f32_32x32x16_bf16(cfr[ks], bfv, Yv, 0, 0, 0); }
#pragma unroll
                for (int q4 = 0; q4 < 4; ++q4) { const f32x4 ac = *(const LAS f32x4*)(ACU + 32 * tt + 8 * q4 + 4 * hh);
#pragma unroll
                    for (int j = 0; j < 4; ++j) Yv[4 * q4 + j] *= __expf(ac[j]); }
            }
            const float act = ACU[crow_c], ddiag = dskip * __builtin_amdgcn_rcpf(DTV[crow_c]);
            const float f1 = tt > 0 ? __expf(act - ACU[32 * tt - 1]) : 1.f;
            for (int st = pt; st <= tt; st += 2) {
                f32x16 X;
#pragma unroll
                for (int i = 0; i < 16; ++i) X[i] = 0.f;
                const LAS unsigned char* bt = BI + 8192 * st;
#pragma unroll
                for (int ks = 0; ks < 8; ++ks) { const bf16x8 af = *(const LAS bf16x8*)(bt + bof[ks]);
                    X = __builtin_amdgcn_mfma_f32_32x32x16_bf16(af, cfr[ks], X, 0, 0, 0); }
                if (st < tt) {
                    asm volatile("; past tile" ::: "memory");
#pragma unroll
                    for (int q4 = 0; q4 < 4; ++q4) { const int sb = 32 * st + 16 * (q4 >> 1) + 8 * hh + 4 * (q4 & 1); const f32x4 e2 = *(const LAS f32x4*)(E2 + sb);
#pragma unroll
                        for (int j = 0; j < 4; ++j) X[4 * q4 + j] *= f1 * e2[j]; }
                } else {
                    asm volatile("; diagonal tile" ::: "memory");
#pragma unroll
                    for (int q4 = 0; q4 < 4; ++q4) { const int sb = 32 * st + 16 * (q4 >> 1) + 8 * hh + 4 * (q4 & 1); const f32x4 as = *(const LAS f32x4*)(ACU + sb);
#pragma unroll
                        for (int j = 0; j < 4; ++j) { const int s = sb + j; float v = X[4 * q4 + j] * __expf(act - as[j]); v = (s <= crow_c) ? v : 0.f; v = (s == crow_c) ? v + ddiag : v; X[4 * q4 + j] = v; } }
                }
                u32x4 pa0, pa1;
                pa0.x = cvtpk(X[0], X[1]); pa0.y = cvtpk(X[2], X[3]); pa0.z = cvtpk(X[4], X[5]); pa0.w = cvtpk(X[6], X[7]);
                pa1.x = cvtpk(X[8], X[9]); pa1.y = cvtpk(X[10], X[11]); pa1.z = cvtpk(X[12], X[13]); pa1.w = cvtpk(X[14], X[15]);
                LAS unsigned char* gp = GT + (tt * (tt + 1) / 2 + st) * 2048 + lane * 16;
                *(LAS u32x4*)gp = pa0; *(LAS u32x4*)(gp + 1024) = pa1;
            }
            LDS_WAIT(); __builtin_amdgcn_s_barrier(); asm volatile("" ::: "memory");
            for (int st = 0; st <= tt; ++st) {
                const LAS unsigned char* gp = GT + (tt * (tt + 1) / 2 + st) * 2048 + lane * 16;
                const bf16x8 pa0 = *(const LAS bf16x8*)gp, pa1 = *(const LAS bf16x8*)(gp + 1024);
                const LAS unsigned char* xt = XI + 8192 * st;
                const bf16x8 xv0 = SSD2_TR(xt, xtr0, xtr1, 0), xv1 = SSD2_TR(xt, xtr0, xtr1, 1);
                Yv = __builtin_amdgcn_mfma_f32_32x32x16_bf16(pa0, xv0, Yv, 0, 0, 0);
                Yv = __builtin_amdgcn_mfma_f32_32x32x16_bf16(pa1, xv1, Yv, 0, 0, 0);
            }
            {
                float sq[16];
#pragma unroll
                for (int i = 0; i < 16; ++i) { const int t = 32 * tt + (i & 3) + 8 * (i >> 2) + 4 * hh;
                    const float z = bf2f(*(const LAS unsigned short*)(XI + off_b(t, 8 + 4 * pt + (r >> 3)) + 2 * (r & 7))); const float y = Yv[i] * silu_f(z);
                    *(LAS unsigned short*)(YT + t * 128 + (32 * pt + r) * 2) = (unsigned short)f2bf(y); sq[i] = y * y; }
#pragma unroll
                for (int i = 0; i < 16; ++i) { sq[i] = dpp_row_sum(sq[i]); sq[i] += shx(sq[i], 16); }
                if (r == 0) {
#pragma unroll
                    for (int i = 0; i < 16; ++i) { const int t = 32 * tt + (i & 3) + 8 * (i >> 2) + 4 * hh; SQT[t * 2 + pt] = sq[i]; }
                }
            }
            LDS_WAIT();
            __builtin_amdgcn_s_barrier(); asm volatile("" ::: "memory");
            {
#pragma unroll
                for (int k = 0; k < 2; ++k) { const int row = (tid >> 3) + 64 * k, ch = tid & 7;
                    *(GAS u32x4*)(Y + (size_t)(b * SEQ + t0 + row) * SSD_DI + hd * 64 + ch * 8) = *(const LAS u32x4*)(YT + row * 128 + ch * 16); }
                if (tid < 128) *(GAS f32x2*)(YSS + (size_t)(b * SEQ + t0 + tid) * 64 + hd * 2) = *(const LAS f32x2*)(SQT + tid * 2);
            }
            {
                const float dec = __expf(a_last);
#pragma unroll
                for (int i = 0; i < 16; ++i) S[i] *= dec;
#pragma unroll
                for (int kb = 0; kb < 8; kb += 4) {
                    bf16x8 af[4], xr[4];
#pragma unroll
                    for (int u = 0; u < 4; ++u) { af[u] = SSD2_TR(BI, btr0, btr1, kb + u); xr[u] = SSD2_TR(XI, xtr0, xtr1, kb + u); }
#pragma unroll
                    for (int u = 0; u < 4; ++u) { const int ks = kb + u;
                        const f32x4 f0 = *(const LAS f32x4*)(FWV + 16 * ks + 8 * hh), f1v = *(const LAS f32x4*)(FWV + 16 * ks + 8 * hh + 4);
                        u32x4 xw; const u32x4 xu = __builtin_bit_cast(u32x4, xr[u]);
                        xw.x = pk2(bflo(xu.x) * f0[0], bfhi(xu.x) * f0[1]); xw.y = pk2(bflo(xu.y) * f0[2], bfhi(xu.y) * f0[3]); xw.z = pk2(bflo(xu.z) * f1v[0], bfhi(xu.z) * f1v[1]); xw.w = pk2(bflo(xu.w) * f1v[2], bfhi(xu.w) * f1v[3]);
                        S = __builtin_amdgcn_mfma_f32_32x32x16_bf16(af[u], __builtin_bit_cast(bf16x8, xw), S, 0, 0, 0); }
                }
#pragma unroll
                for (int q4 = 0; q4 < 4; ++q4) { u32x2 wv; wv.x = cvtpk(S[4 * q4], S[4 * q4 + 1]); wv.y = cvtpk(S[4 * q4 + 2], S[4 * q4 + 3]);
                    *(LAS u32x2*)(SB + off_b(prow, 4 * nt + q4) + 8 * hh) = wv; }
            }
        }
        __builtin_amdgcn_s_barrier();
    }
    VM_WAIT(); __builtin_amdgcn_s_barrier();
#undef SSD2_PREFETCH
#undef SSD2_TR
}
#define PHASE_PARAMS() const Params& P = Pk; unsigned char* ws = P.ws; (void)ws
__global__ void __launch_bounds__(NTHR, 2) fwd_kernel(Params Pk) {
    extern __shared__ __attribute__((aligned(16))) unsigned char lds_raw[];
    Ctx C;
    C.lds = (LAS unsigned char*)lds_raw;
    C.wave = __builtin_amdgcn_readfirstlane((int)threadIdx.x >> 6); C.tid = TID_FROM_WAVE(C.wave); C.lane = C.tid & 63;
    C.G = gridDim.x; C.gw = blockIdx.x * NWAVES + C.wave; C.NGW = C.G * NWAVES;
    volatile LAS unsigned* MISC = (volatile LAS unsigned*)(C.lds + MISC_OFF);
    if (C.tid < 16) MISC[C.tid] = 0u;
    __syncthreads();
    XcdBarrier bar; { PHASE_PARAMS(); bar = xcd_barrier_post((unsigned*)(ws + WS_CTL) + CW_BAR, MISC + 8, TID_FROM_WAVE(C.wave) == 0); }
#define GRID_BAR() xcd_barrier(bar, TID_FROM_WAVE(C.wave) == 0)
#define LOCAL_BAR() __syncthreads()

#define WSM ((bf16_t*)(ws + WS_WSMALL))
#define SS ((float*)(ws + WS_SS))
    LAS unsigned char* ring = C.lds;
    LAS float* XS = (LAS float*)(C.lds + XS_OFF);
    const int G = C.G, cb = blockIdx.x;

    { PHASE_PARAMS(); p0_prologue(P, C); }
    GRID_BAR();
    {   PHASE_PARAMS();
        SchedHyIn S{(const char*)(ws + WS_HNA), (const char*)(WSM + WO_HYIN), (const char*)(WSM + WO_HYV), G, cb};
        bf16_t* Q = (bf16_t*)(ws + WS_QKU);
        EpiHyIn E{Q, Q + (size_t)NTOK * 512, Q + (size_t)2 * NTOK * 512, (bf16_t*)(ws + WS_VT), P.hy_qn, P.hy_kn, (const float*)(ws + WS_ROPE), (float*)(ws + WS_KMP)};
        pg8::gemm_phase<false, false>(ring, C.wave, 2048, 2048, 2048, S, E);
    }
    GRID_BAR();
    { PHASE_PARAMS(); moba_mfma(P, C); }
    { PHASE_PARAMS(); pool_mfma(P, C); }
    GRID_BAR();
    {   PHASE_PARAMS();
        SchedPlain S{(const char*)(ws + WS_AP), (const char*)(WSM + WO_HYOUT), 128, 4, 2048, 2048, G, cb};
        EpiRes<XA_FP8 != 0, true> E{P.x, P.out, (void*)(ws + WS_HNA), P.xa_norm, SS, 1.f};
        pg8::gemm_phase<false, false>(ring, C.wave, 2048, 2048, 2048, S, E);
    }
    GRID_BAR();
    {   PHASE_PARAMS();
        SchedXaProj S{(const char*)(ws + WS_HNA), (const char*)(ws + WS_W8 + W8_XAQ), (const char*)(ws + WS_MEMN), (const char*)(ws + WS_W8 + W8_XAK), (const char*)(ws + WS_W8 + W8_XAV), 0, 0, 2, G, cb};
        EpiXaProj E{(bf16_t*)(ws + WS_QXA), (bf16_t*)(ws + WS_KXA), (bf16_t*)(ws + WS_VTXA), P.xa_qn, P.xa_kn, SS, XS};
        pg8::gemm_phase<false, XA_FP8 != 0>(ring, C.wave, 1024 * XAB, 1024 * XAB, 1024 * XAB, S, E);
    }
    GRID_BAR();
    {   PHASE_PARAMS();
        SchedXaAttn S{(const char*)(ws + WS_QXA), (const char*)(ws + WS_KXA), (size_t)256 * 2048, (size_t)512, G, cb};
        EpiXaS E{(bf16_t*)(ws + WS_PXA), (float*)(ws + WS_PSUM)};
        pg8::gemm_phase<true, false>(ring, C.wave, 2048, 2048, 512, S, E);
    }
    LOCAL_BAR();
    {   PHASE_PARAMS();
        SchedXaAttn S{(const char*)(ws + WS_PXA), (const char*)(ws + WS_VTXA), (size_t)512, (size_t)256 * 4096, G, cb};
        EpiXaO E{(unsigned char*)(ws + WS_OXA), (const float*)(ws + WS_PSUM)};
        pg8::gemm_phase<true, false>(ring, C.wave, 2048, 4096, 512, S, E);
    }
    GRID_BAR();
    {   PHASE_PARAMS();
        SchedPlain S{(const char*)(ws + WS_OXA), (const char*)(ws + WS_W8 + W8_XAO), 128, 4, 1024 * XAB, 1024 * XAB, G, cb};
        EpiRes<FFN_FP8 != 0> E{P.out, P.out, (void*)(ws + WS_HNA), P.ffn_norm, SS, 1.f / XAWS};
        pg8::gemm_phase<false, XA_FP8 != 0>(ring, C.wave, 1024 * XAB, 1024 * XAB, 1024 * XAB, S, E);
    }
    GRID_BAR();
    {   PHASE_PARAMS();
#if FFN_FP8
        SchedPlain S{(const char*)(ws + WS_HNA), (const char*)(ws + WS_W8 + W8_FGU), 128, 22, 1024, 1024, G, cb};
        EpiGU8 E{(unsigned char*)(ws + WS_HID), DFF, SS, nullptr};
        pg8::gemm_phase<false, true>(ring, C.wave, 1024, 1024, 1024, S, E);
#else
        SchedPlain S{(const char*)(ws + WS_HNA), (const char*)(ws + WS_W8 + W8_FGU), 128, 22, 2048, 2048, G, cb};
        EpiGU E{(bf16_t*)(ws + WS_HID), DFF, SS, nullptr, 0};
        pg8::gemm_phase<false, false>(ring, C.wave, 2048, 2048, 2048, S, E);
#endif
    }
    GRID_BAR();
    {   PHASE_PARAMS();
#if FFN_FP8
        SchedPlain S{(const char*)(ws + WS_HID), (const char*)(ws + WS_W8 + W8_FDN), 128, 4, DFF, DFF, G, cb};
        EpiRes<false> E{P.out, P.out, (void*)(ws + WS_HNA), P.mix_norm + DM, SS, 1.f / (MOE_WSCALE * MOE_HSCALE)};
        pg8::gemm_phase<false, true>(ring, C.wave, DFF, DFF, DFF, S, E);
#else
        SchedPlain S{(const char*)(ws + WS_HID), (const char*)(ws + WS_W8 + W8_FDN), 128, 4, DFF * 2, DFF * 2, G, cb};
        EpiRes<false> E{P.out, P.out, (void*)(ws + WS_HNA), P.mix_norm + DM, SS, 1.f};
        pg8::gemm_phase<false, false>(ring, C.wave, DFF * 2, DFF * 2, DFF * 2, S, E);
#endif
    }
    GRID_BAR();
    {   PHASE_PARAMS();
        SchedPlain S{(const char*)(ws + WS_HNA), (const char*)(WSM + WO_SIN), 128, 20, 2048, 2048, G, cb};
        EpiSsdIn E{(bf16_t*)(ws + WS_ZX), (float*)(ws + WS_DT), SS, (bf16_t*)(ws + WS_HALO)};
        pg8::gemm_phase<false, false>(ring, C.wave, 2048, 2048, 2048, S, E);
    }
    GRID_BAR();
    { PHASE_PARAMS(); ssd_conv_prepass(P, C); }
    GRID_BAR();
    { PHASE_PARAMS(); ssd_chunked2(P, C, (bf16_t*)(ws + WS_Y), (float*)(ws + WS_YSS)); }
    GRID_BAR();
    {   PHASE_PARAMS();
        SchedPlain S{(const char*)(ws + WS_Y), (const char*)(WSM + WO_SOUT), 128, 4, 4096, 4096, G, cb};
        EpiResSeg E{P.out, P.out, (void*)(ws + WS_HNA2), P.xa_norm + DM, SS, (const float*)(ws + WS_YSS), XS};
        pg8::gemm_phase<false, false, true>(ring, C.wave, 4096, 4096, 4096, S, E);
    }
    GRID_BAR();
    {   PHASE_PARAMS();
        SchedXaProj S{(const char*)(ws + WS_HNA2), (const char*)(ws + WS_W8 + W8_XAQ + (size_t)1024 * 1024 * XAB), (const char*)(ws + WS_MEMN), (const char*)(ws + WS_W8 + W8_XAK), (const char*)(ws + WS_W8 + W8_XAV), 1, 0, 0, G, cb};
        EpiXaProj E{(bf16_t*)(ws + WS_QXA1), (bf16_t*)(ws + WS_KXA), (bf16_t*)(ws + WS_VTXA), P.xa_qn + 256, P.xa_kn, SS, XS};
        pg8::gemm_phase<false, XA_FP8 != 0>(ring, C.wave, 1024 * XAB, 1024 * XAB, 1024 * XAB, S, E);
    }
    LOCAL_BAR();
    {   PHASE_PARAMS();
        SchedXaAttn S{(const char*)(ws + WS_QXA1), (const char*)(ws + WS_KXA + (size_t)2048 * 2048), (size_t)256 * 2048, (size_t)512, G, cb};
        EpiXaS E{(bf16_t*)(ws + WS_PXA1), (float*)(ws + WS_PSUM)};
        pg8::gemm_phase<true, false>(ring, C.wave, 2048, 2048, 512, S, E);
    }
    LOCAL_BAR();
    {   PHASE_PARAMS();
        SchedXaAttn S{(const char*)(ws + WS_PXA1), (const char*)(ws + WS_VTXA + (size_t)1024 * 4096), (size_t)512, (size_t)256 * 4096, G, cb};
        EpiXaO E{(unsigned char*)(ws + WS_OXA1), (const float*)(ws + WS_PSUM)};
        pg8::gemm_phase<true, false>(ring, C.wave, 2048, 4096, 512, S, E);
    }
    GRID_BAR();
    {   PHASE_PARAMS();
        SchedPlain S{(const char*)(ws + WS_OXA1), (const char*)(ws + WS_W8 + W8_XAO + (size_t)1024 * 1024 * XAB), 128, 4, 1024 * XAB, 1024 * XAB, G, cb};
        EpiResRt E{P.out, P.out, (void*)(ws + WS_HNA3), P.ffn_norm + DM, SS, 1.f / XAWS, P.router, (float*)(ws + WS_LP)};
        pg8::gemm_phase<false, XA_FP8 != 0>(ring, C.wave, 1024 * XAB, 1024 * XAB, 1024 * XAB, S, E);
    }
    GRID_BAR();
    { PHASE_PARAMS(); moe_router(P, C); }
    __syncthreads();
    { PHASE_PARAMS(); moe_weight_cvt<false>(P, C); }
    GRID_BAR();
    { PHASE_PARAMS(); moe_scatter(P, C); }
    GRID_BAR();
    {
        PHASE_PARAMS();
        const int* blke = (const int*)(ws + WS_ROUTE + RT_BLKE); const int nb = __builtin_amdgcn_readfirstlane(blke[264]);
        { const int t_ = TID_FROM_WAVE(C.wave); if (t_ < 264) ((LAS int*)XS)[t_] = blke[t_]; __syncthreads(); }
        const unsigned char* WM = (const unsigned char*)(ws + WS_WMOE8);
        {
            SchedMoe<(size_t)256 * 1024, (size_t)7168 * 1024, (size_t)256 * 1024, 28> S{(const char*)(ws + WS_XBUF8), (const char*)(WM + WM8_GU), (const LAS int*)XS, nb, G, cb};
            EpiGU8 E{(unsigned char*)(ws + WS_HMOE8), DFE, nullptr, (const float*)(ws + WS_ROUTE + RT_RSD)};
            pg8::gemm_phase<false, true>(ring, C.wave, 1024, 1024, 1024, S, E);
        }
        { PHASE_PARAMS(); __syncthreads(); moe_weight_cvt<true>(P, C); }
        GRID_BAR();
        {
            SchedMoeDn<(size_t)256 * DFE, (size_t)1024 * DFE, (size_t)256 * DFE> S{(const char*)(ws + WS_HMOE8), (const char*)(WM + WM8_DN), (const LAS int*)XS, nb, G, cb};
            EpiMoeDn E{(bf16_t*)(ws + WS_YBUF), (float*)(ws + WS_XBUF8), 1.f / (MOE_WSCALE * MOE_HSCALE)};
            pg8::gemm_phase<false, true>(ring, C.wave, DFE, DFE, DFE, S, E);
        }
        GRID_BAR();
    }
    { PHASE_PARAMS(); moe_combine(P, C); }
}

extern "C" void kernel_launch(void* const* d_in, const int* in_sizes, int n_in, void* d_out, int out_size, void* d_ws, size_t ws_size, hipStream_t stream) {
    static int grid = 0;
    if (grid == 0) {
        if (n_in != 33 || out_size != NTOK * DM || ws_size < WS_END) { fprintf(stderr, "kernel_launch: unexpected shapes (n_in %d, out %d, ws %zu, need %zu)\n", n_in, out_size, ws_size, (size_t)WS_END); grid = -1; return; }
        int dev = 0, cus = 0, per_cu = 0;
        if (hipGetDevice(&dev) != hipSuccess || hipDeviceGetAttribute(&cus, hipDeviceAttributeMultiprocessorCount, dev) != hipSuccess) { grid = -1; return; }
        if (hipFuncSetAttribute((const void*)fwd_kernel, hipFuncAttributeMaxDynamicSharedMemorySize, LDS_BYTES) != hipSuccess) { fprintf(stderr, "kernel_launch: hipFuncSetAttribute failed\n"); grid = -1; return; }
        if (hipOccupancyMaxActiveBlocksPerMultiprocessor(&per_cu, (const void*)fwd_kernel, NTHR, LDS_BYTES) != hipSuccess || per_cu < 1) { fprintf(stderr, "kernel_launch: occupancy query says %d\n", per_cu); }
        (void)hipGetLastError();
        grid = cus;
    }
    if (grid < 0) return;
    (void)hipMemsetAsync((char*)d_ws + WS_CTL, 0, CTL_ZERO_BYTES, stream);
    Params p{};
    p.x = (const float*)d_in[0]; p.mem = (const float*)d_in[1]; p.pos = (const int*)d_in[2];
    p.mix_norm = (const float*)d_in[3]; p.xa_norm = (const float*)d_in[4]; p.mem_norm = (const float*)d_in[5]; p.ffn_norm = (const float*)d_in[6];
    p.xa_wq = (const float*)d_in[7]; p.xa_wkv = (const float*)d_in[8]; p.xa_qn = (const float*)d_in[9]; p.xa_kn = (const float*)d_in[10]; p.xa_wo = (const float*)d_in[11];
    p.hy_w_in = (const float*)d_in[12]; p.hy_qn = (const float*)d_in[13]; p.hy_kn = (const float*)d_in[14]; p.pool_w = (const float*)d_in[15]; p.pool_scale = (const float*)d_in[16]; p.hy_w_out = (const float*)d_in[17];
    p.ffn_wg = (const float*)d_in[18]; p.ffn_wu = (const float*)d_in[19]; p.ffn_wd = (const float*)d_in[20];
    p.ssd_w_in = (const float*)d_in[21]; p.conv_w = (const float*)d_in[22]; p.conv_b = (const float*)d_in[23]; p.dt_bias = (const float*)d_in[24]; p.a_log = (const float*)d_in[25]; p.ssd_d = (const float*)d_in[26];
    p.ssd_norm = (const float*)d_in[27]; p.ssd_w_out = (const float*)d_in[28];
    p.router = (const float*)d_in[29]; p.moe_wg = (const float*)d_in[30]; p.moe_wu = (const float*)d_in[31]; p.moe_wd = (const float*)d_in[32];
    p.out = (float*)d_out; p.ws = (unsigned char*)d_ws; p.ph_lo = 0; p.ph_hi = 100;
    hipLaunchKernelGGL(fwd_kernel, dim3(grid), dim3(NTHR), LDS_BYTES, stream, p);
    const hipError_t le = hipPeekAtLastError();
    if (le != hipSuccess) fprintf(stderr, "kernel_launch: launch failed: %s\n", hipGetErrorName(le));
}
```
